# Optimizing an MI355X kernel written in HIP

```python
import math
import jax, jax.numpy as jnp
from jax import lax
import numpy as np

D_MODEL = 1024
BATCH = 32
SEQ = 256
DEPTH = 2
DEC_BATCH = 4
DEC_SEQ = 1024
PAST_LEN = 256

GRID_W = 64
N_EVEN = (DEPTH + 1) // 2
N_ODD = DEPTH // 2
W_A = D_MODEL
SSM_GROUP = 16
G_A = W_A // SSM_GROUP
P_A = 64
DT_MIN = 1e-3
DT_MAX = 1e-1
DH = 64
H_B = D_MODEL // (2 * DH)
W_B = H_B * 2 * DH
QB = 128
ROPE_BASE = 10000.0
ROT_HALF = DH // 2
ROT_FREQS = DH // 4
E_IN = 2 * W_A + 4 * W_B
W_C = 2 * D_MODEL
NG_C = 8
GC_C = W_C // NG_C
ALPHA = (2 * DEPTH) ** 0.25
BETA = (8 * DEPTH) ** -0.25
LN_EPS = 1e-5

kernel_name = 'hybrid_s5_diffattn_fnet_prefix_diffusion_step'

F32 = jnp.float32


def _ln(x):
    xf = x.astype(F32)
    mu = jnp.mean(xf, axis=-1, keepdims=True)
    var = jnp.mean(jnp.square(xf - mu), axis=-1, keepdims=True)
    return (xf - mu) * lax.rsqrt(var + LN_EPS)


def _modulate_input(x, cond, w_mod_l, b_mod_l):
    m = jax.nn.silu(cond.astype(F32)) @ w_mod_l.astype(F32) + b_mod_l.astype(F32)
    shift, scale, gate = jnp.split(m[:, None, :], 3, axis=-1)
    h = (_ln(x) * (1.0 + scale) + shift).astype(x.dtype)
    return h, gate


def _post_norm(x, gate, out, ln_g_l, ln_b_l):
    z = ALPHA * x.astype(F32) + gate * out.astype(F32)
    return (_ln(z) * ln_g_l.astype(F32) + ln_b_l.astype(F32)).astype(x.dtype)


def _axial_rope(L):
    rows = L // GRID_W
    row = jnp.repeat(jnp.arange(rows), GRID_W).astype(F32)
    col = jnp.tile(jnp.arange(GRID_W), rows).astype(F32)
    freqs = ROPE_BASE ** (-jnp.arange(ROT_FREQS, dtype=F32) / ROT_FREQS)
    ang = jnp.concatenate([row[:, None] * freqs, col[:, None] * freqs], axis=-1)
    return jnp.cos(ang), jnp.sin(ang)


def _apply_rope(x, cos, sin):
    xf = x.astype(F32)
    x1, x2 = xf[..., :ROT_HALF], xf[..., ROT_HALF:]
    c = cos[None, :, None, None, :]
    s = sin[None, :, None, None, :]
    return jnp.concatenate([x1 * c - x2 * s, x1 * s + x2 * c], axis=-1).astype(x.dtype)


def _diff_attn(q, k, v, lam):
    bsz, lq = q.shape[0], q.shape[1]
    qb = min(QB, lq)
    nb = lq // qb
    qs = jnp.moveaxis(q.reshape(bsz, nb, qb, H_B, 2, DH), 1, 0)
    kf = k.astype(F32)
    vf = v.astype(F32)

    def block(qi):
        s = jnp.einsum('bqhmd,bkhmd->bhmqk', qi.astype(F32), kf) * (DH ** -0.5)
        p = jax.nn.softmax(s, axis=-1)
        a = p[:, :, 0] - lam * p[:, :, 1]
        return jnp.einsum('bhqk,bkhe->bqhe', a, vf)

    o = lax.map(block, qs)
    return jnp.moveaxis(o, 0, 1).reshape(bsz, lq, H_B, 2 * DH)


def _ssm_combine(e1, e2):
    a1r, a1i, b1r, b1i = e1
    a2r, a2i, b2r, b2i = e2
    return (a2r * a1r - a2i * a1i,
            a2r * a1i + a2i * a1r,
            a2r * b1r - a2i * b1i + b2r,
            a2r * b1i + a2i * b1r + b2i)


def _s5_bidir(u, lam_re, lam_im, log_dt, b_re, b_im, c_re, c_im, d_skip, h0_re, h0_im):
    bsz, L = u.shape[0], u.shape[1]
    uf = u.astype(F32).reshape(bsz, L, G_A, SSM_GROUP)
    y = uf * d_skip.astype(F32).reshape(G_A, SSM_GROUP)
    fin_re, fin_im = [], []
    for d in range(2):
        lr = lam_re[d].astype(F32)
        li = lam_im[d].astype(F32)
        dt = jnp.exp(log_dt[d].astype(F32))[:, None]
        mag = jnp.exp(lr * dt)
        ar = mag * jnp.cos(li * dt)
        ai = mag * jnp.sin(li * dt)
        den = lr * lr + li * li
        fr = ((ar - 1.0) * lr + ai * li) / den
        fi = (ai * lr - (ar - 1.0) * li) / den
        br = b_re[d].astype(F32)
        bi = b_im[d].astype(F32)
        bbr = fr[..., None] * br - fi[..., None] * bi
        bbi = fr[..., None] * bi + fi[..., None] * br
        xr = jnp.einsum('blgn,gpn->blgp', uf, bbr)
        xi = jnp.einsum('blgn,gpn->blgp', uf, bbi)
        t0 = 0 if d == 0 else L - 1
        h0r = h0_re[:, d].astype(F32)
        h0i = h0_im[:, d].astype(F32)
        xr = xr.at[:, t0].add(ar * h0r - ai * h0i)
        xi = xi.at[:, t0].add(ar * h0i + ai * h0r)
        arb = jnp.broadcast_to(ar, xr.shape)
        aib = jnp.broadcast_to(ai, xr.shape)
        _, _, hr, hi = lax.associative_scan(_ssm_combine, (arb, aib, xr, xi), reverse=(d == 1), axis=1)
        y = y + jnp.einsum('blgp,gnp->blgn', hr, c_re[d].astype(F32)) \
              - jnp.einsum('blgp,gnp->blgn', hi, c_im[d].astype(F32))
        tf = L - 1 if d == 0 else 0
        fin_re.append(hr[:, tf])
        fin_im.append(hi[:, tf])
    return y.reshape(bsz, L, W_A), jnp.stack(fin_re, axis=1), jnp.stack(fin_im, axis=1)


def _even_layer(x, cond, w_mod_l, b_mod_l, ln_g_l, ln_b_l, pe, lam_init, rope, ctx_k, ctx_v, h0_re, h0_im):
    bsz, L = x.shape[0], x.shape[1]
    h, gate = _modulate_input(x, cond, w_mod_l, b_mod_l)
    proj = h @ pe['w_in']
    u_a, z_a, q, k, v, z_b = jnp.split(
        proj, [W_A, 2 * W_A, 2 * W_A + W_B, 2 * W_A + 2 * W_B, 2 * W_A + 3 * W_B], axis=-1)
    y_a, hf_re, hf_im = _s5_bidir(u_a, pe['lam_re'], pe['lam_im'], pe['log_dt'], pe['b_re'], pe['b_im'],
                                  pe['c_re'], pe['c_im'], pe['d'], h0_re, h0_im)
    g_a = jax.nn.gelu(y_a.astype(x.dtype))
    y_a = g_a * jax.nn.sigmoid(g_a @ pe['w_glu'] + pe['b_glu'])
    y_a = y_a * jax.nn.silu(z_a)
    q = q.reshape(bsz, L, H_B, 2, DH)
    k = k.reshape(bsz, L, H_B, 2, DH)
    v = v.reshape(bsz, L, H_B, 2 * DH)
    if rope is None:
        q_r, k_all, v_all = q, k, v
    else:
        cos, sin = rope
        q_r = _apply_rope(q, cos, sin)
        k_all = jnp.concatenate([ctx_k.astype(k.dtype), _apply_rope(k, cos, sin)], axis=1)
        v_all = jnp.concatenate([ctx_v.astype(v.dtype), v], axis=1)
    lam = (jnp.exp(jnp.sum(pe['lq1'].astype(F32) * pe['lk1'].astype(F32)))
           - jnp.exp(jnp.sum(pe['lq2'].astype(F32) * pe['lk2'].astype(F32))) + lam_init)
    o = _diff_attn(q_r, k_all, v_all, lam)
    o = o * lax.rsqrt(jnp.mean(jnp.square(o), axis=-1, keepdims=True) + LN_EPS)
    o = o * pe['subln_g'].astype(F32) * (1.0 - lam_init)
    y_b = o.reshape(bsz, L, W_B).astype(x.dtype) * jax.nn.silu(z_b)
    out = jnp.concatenate([y_a.astype(x.dtype), y_b], axis=-1) @ pe['w_out']
    return _post_norm(x, gate, out, ln_g_l, ln_b_l), k, v, hf_re, hf_im


def _odd_layer(x, cond, w_mod_l, b_mod_l, ln_g_l, ln_b_l, w_in, w_fno, b_fno, w_out):
    bsz, L = x.shape[0], x.shape[1]
    h, gate = _modulate_input(x, cond, w_mod_l, b_mod_l)
    u, z = jnp.split(h @ w_in, 2, axis=-1)
    uf = u.astype(F32).reshape(bsz, L, NG_C, GC_C)
    mixed = jnp.real(jnp.fft.fft2(uf, axes=(1, 3), norm='ortho')).reshape(bsz, L, W_C).astype(x.dtype)
    y = (mixed @ w_fno + b_fno) * jax.nn.silu(z)
    return _post_norm(x, gate, y @ w_out, ln_g_l, ln_b_l)


def setup_inputs(seed: int = 0) -> dict:
    key = jax.random.key(seed)
    ks = jax.random.split(key, 40)

    def nrm(k, shape, s):
        return jax.random.normal(k, shape, F32) * s

    n_idx = jnp.arange(P_A, dtype=F32)
    return {
        'x_prompt': nrm(ks[0], (BATCH, SEQ, D_MODEL), 1.0),
        'x_sample': nrm(ks[1], (DEC_BATCH, DEC_SEQ, D_MODEL), 1.0),
        'cache_k': nrm(ks[2], (DEC_BATCH, N_EVEN, PAST_LEN, H_B, 2, DH), 1.0),
        'cache_v': nrm(ks[3], (DEC_BATCH, N_EVEN, PAST_LEN, H_B, 2 * DH), 1.0),
        'state_ssm_re': nrm(ks[4], (DEC_BATCH, N_EVEN, 2, G_A, P_A), 0.5),
        'state_ssm_im': nrm(ks[5], (DEC_BATCH, N_EVEN, 2, G_A, P_A), 0.5),
        'c': nrm(ks[6], (DEC_BATCH, D_MODEL), 1.0),
        'c_ctx': nrm(ks[7], (D_MODEL,), 1.0),
        'w_mod': nrm(ks[8], (DEPTH, D_MODEL, 3 * D_MODEL), D_MODEL ** -0.5),
        'b_mod': nrm(ks[9], (DEPTH, 3 * D_MODEL), 0.02),
        'ln_g': 1.0 + nrm(ks[10], (DEPTH, D_MODEL), 0.02),
        'ln_b': nrm(ks[11], (DEPTH, D_MODEL), 0.02),
        'w_in_e': nrm(ks[12], (N_EVEN, D_MODEL, E_IN), D_MODEL ** -0.5),
        'ssm_lam_re': -0.5 + nrm(ks[13], (N_EVEN, 2, G_A, P_A), 0.01),
        'ssm_lam_im': math.pi * n_idx + nrm(ks[14], (N_EVEN, 2, G_A, P_A), 0.01),
        'ssm_log_dt': jax.random.uniform(ks[15], (N_EVEN, 2, G_A), F32, math.log(DT_MIN), math.log(DT_MAX)),
        'ssm_b_re': nrm(ks[16], (N_EVEN, 2, G_A, P_A, SSM_GROUP), (2 * SSM_GROUP) ** -0.5),
        'ssm_b_im': nrm(ks[17], (N_EVEN, 2, G_A, P_A, SSM_GROUP), (2 * SSM_GROUP) ** -0.5),
        'ssm_c_re': nrm(ks[18], (N_EVEN, 2, G_A, SSM_GROUP, P_A), P_A ** -0.5),
        'ssm_c_im': nrm(ks[19], (N_EVEN, 2, G_A, SSM_GROUP, P_A), P_A ** -0.5),
        'ssm_d': nrm(ks[20], (N_EVEN, W_A), 1.0),
        'w_glu': nrm(ks[21], (N_EVEN, W_A, W_A), W_A ** -0.5),
        'b_glu': nrm(ks[22], (N_EVEN, W_A), 0.02),
        'lam_q1': nrm(ks[23], (N_EVEN, DH), 0.1),
        'lam_k1': nrm(ks[24], (N_EVEN, DH), 0.1),
        'lam_q2': nrm(ks[25], (N_EVEN, DH), 0.1),
        'lam_k2': nrm(ks[26], (N_EVEN, DH), 0.1),
        'subln_g': 1.0 + nrm(ks[27], (N_EVEN, 2 * DH), 0.02),
        'w_out_e': nrm(ks[28], (N_EVEN, W_A + W_B, D_MODEL), (W_A + W_B) ** -0.5 * BETA),
        'w_in_o': nrm(ks[29], (N_ODD, D_MODEL, 2 * W_C), D_MODEL ** -0.5),
        'w_fno': nrm(ks[30], (N_ODD, W_C, W_C), W_C ** -0.5),
        'b_fno': nrm(ks[31], (N_ODD, W_C), 0.02),
        'w_out_o': nrm(ks[32], (N_ODD, W_C, D_MODEL), W_C ** -0.5 * BETA),
    }


def reference(x_prompt, x_sample, cache_k, cache_v, state_ssm_re, state_ssm_im, c, c_ctx,
              w_mod, b_mod, ln_g, ln_b, w_in_e, ssm_lam_re, ssm_lam_im, ssm_log_dt,
              ssm_b_re, ssm_b_im, ssm_c_re, ssm_c_im, ssm_d, w_glu, b_glu,
              lam_q1, lam_k1, lam_q2, lam_k2, subln_g, w_out_e, w_in_o, w_fno, b_fno, w_out_o):
    rope = _axial_rope(x_sample.shape[1])
    cond_ctx = c_ctx[None, :]
    bp = x_prompt.shape[0]
    xp, xs = x_prompt, x_sample
    new_k, new_v, new_sr, new_si = [], [], [], []
    for layer in range(DEPTH):
        wm, bm, lg, lb = w_mod[layer], b_mod[layer], ln_g[layer], ln_b[layer]
        if layer % 2 == 0:
            e = layer // 2
            lam_init = 0.8 - 0.6 * math.exp(-0.3 * layer)
            pe = dict(w_in=w_in_e[e], lam_re=ssm_lam_re[e], lam_im=ssm_lam_im[e], log_dt=ssm_log_dt[e],
                      b_re=ssm_b_re[e], b_im=ssm_b_im[e], c_re=ssm_c_re[e], c_im=ssm_c_im[e], d=ssm_d[e],
                      w_glu=w_glu[e], b_glu=b_glu[e], lq1=lam_q1[e], lk1=lam_k1[e], lq2=lam_q2[e],
                      lk2=lam_k2[e], subln_g=subln_g[e], w_out=w_out_e[e])
            zeros = jnp.zeros((bp, 2, G_A, P_A), F32)
            xp, k_ctx, v_ctx, s_re, s_im = _even_layer(xp, cond_ctx, wm, bm, lg, lb, pe, lam_init,
                                                       None, None, None, zeros, zeros)
            new_k.append(k_ctx)
            new_v.append(v_ctx)
            new_sr.append(s_re)
            new_si.append(s_im)
            xs = _even_layer(xs, c, wm, bm, lg, lb, pe, lam_init, rope, cache_k[:, e], cache_v[:, e],
                             state_ssm_re[:, e], state_ssm_im[:, e])[0]
        else:
            o = layer // 2
            xp = _odd_layer(xp, cond_ctx, wm, bm, lg, lb, w_in_o[o], w_fno[o], b_fno[o], w_out_o[o])
            xs = _odd_layer(xs, c, wm, bm, lg, lb, w_in_o[o], w_fno[o], b_fno[o], w_out_o[o])
    return (xp, xs, jnp.stack(new_k, axis=1), jnp.stack(new_v, axis=1),
            jnp.stack(new_sr, axis=1), jnp.stack(new_si, axis=1))
```

```cpp
#include <hip/hip_runtime.h>
#include <hip/hip_cooperative_groups.h>
#include <cstdio>
#include <cstdint>
namespace cg = cooperative_groups;

typedef unsigned short bf16_t;
typedef short bf16x8 __attribute__((ext_vector_type(8)));
typedef short s16x4 __attribute__((ext_vector_type(4)));
typedef float f32x4 __attribute__((ext_vector_type(4)));
typedef float f32x2 __attribute__((ext_vector_type(2)));
typedef float f32x16 __attribute__((ext_vector_type(16)));
typedef unsigned u32x4 __attribute__((ext_vector_type(4)));
typedef unsigned u32x2 __attribute__((ext_vector_type(2)));
typedef __bf16 bfv2 __attribute__((ext_vector_type(2)));

#define DI __device__ __forceinline__

constexpr int NTOK = 12288, NPTOK = 8192, DM = 1024;
constexpr float LN_EPS = 1e-5f;
constexpr float ALPHA = 1.41421356237f;
constexpr float LAM_INIT = 0.2f;
constexpr float LOG2E = 1.4426950408889634f;

constexpr size_t MiB = 1024ull * 1024ull;
constexpr size_t OFF_MOD   = 0;
constexpr size_t OFF_ROPEC = 256 * 1024;
constexpr size_t OFF_ROPES = 384 * 1024;
constexpr size_t OFF_LAM   = 512 * 1024;
constexpr size_t OFF_BAR   = 1024 * 1024;
constexpr size_t OFF_WDFT  = 2 * MiB;
constexpr size_t OFF_DL256 = 2 * MiB + 256 * 1024;
constexpr size_t OFF_DL1K  = 3 * MiB;
constexpr size_t OFF_WINE  = 8 * MiB;
constexpr size_t OFF_WGLU  = 20 * MiB;
constexpr size_t OFF_WOUTE = 22 * MiB;
constexpr size_t OFF_WS    = 26 * MiB;
constexpr size_t OFF_WY    = 34 * MiB;
constexpr size_t OFF_H0    = 50 * MiB;
constexpr size_t OFF_UCOMB = 74 * MiB;
constexpr size_t OFF_YAB   = 122 * MiB;
constexpr size_t OFF_Q     = 170 * MiB;
constexpr size_t OFF_KP    = 194 * MiB;
constexpr size_t OFF_KS    = 210 * MiB;
constexpr size_t OFF_VTP   = 220 * MiB;
constexpr size_t OFF_VTS   = 236 * MiB;
constexpr size_t OFF_WINO  = 8 * MiB;
constexpr size_t OFF_WFNO  = 26 * MiB;
constexpr size_t OFF_WOUTO = 16 * MiB;
constexpr size_t OFF_H1    = 34 * MiB;
constexpr size_t OFF_UO    = 58 * MiB;
constexpr size_t OFF_ZO    = 106 * MiB;
constexpr size_t OFF_TP    = 154 * MiB;
constexpr size_t OFF_TS    = 218 * MiB;
constexpr size_t OFF_Y1    = 154 * MiB;
constexpr size_t OUT_Y  = 0;
constexpr size_t OUT_CK = 12582912;
constexpr size_t OUT_CV = 20971520;
constexpr size_t OUT_SR = 29360128;
constexpr size_t OUT_SI = 29622272;

struct Params {
    const float *x_prompt, *x_sample, *cache_k, *cache_v, *st_re, *st_im, *c, *c_ctx, *w_mod, *b_mod, *ln_g, *ln_b, *w_in_e,
        *lam_re, *lam_im, *log_dt, *b_re, *b_im, *c_re, *c_im, *ssm_d, *w_glu, *b_glu, *lq1, *lk1, *lq2, *lk2, *subln_g, *w_out_e,
        *w_in_o, *w_fno, *b_fno, *w_out_o;
    float* out;
    char* ws;
};

DI float bf2f(bf16_t b) { return __uint_as_float(((unsigned)b) << 16); }
DI unsigned pk2(float lo, float hi) { f32x2 v = {lo, hi}; bfv2 b = __builtin_convertvector(v, bfv2); return __builtin_bit_cast(unsigned, b); }
DI bf16_t f2bf(float x) { return (bf16_t)(pk2(x, 0.f) & 0xffffu); }
DI u32x2 pk4(f32x4 v) { u32x2 r; r.x = pk2(v[0], v[1]); r.y = pk2(v[2], v[3]); return r; }
DI f32x4 unpk4(u32x2 r) { f32x4 v; v[0] = __uint_as_float(r.x << 16); v[1] = __uint_as_float(r.x & 0xffff0000u); v[2] = __uint_as_float(r.y << 16); v[3] = __uint_as_float(r.y & 0xffff0000u); return v; }
DI float siluf(float x) { return x / (1.f + __expf(-x)); }
DI float gelu_tanh(float x) { float u = 0.7978845608028654f * (x + 0.044715f * x * x * x); float e = __expf(2.f * u); return 0.5f * x * (2.f - 2.f / (1.f + e)); }
DI float wave_sum(float v) {
#pragma unroll
    for (int o = 32; o; o >>= 1) v += __shfl_xor(v, o);
    return v;
}
DI int cond_of(int tok) { return tok < NPTOK ? 0 : 1 + ((tok - NPTOK) >> 10); }
DI const float* xin(const Params& p, int tok) { return tok < NPTOK ? p.x_prompt + (size_t)tok * DM : p.x_sample + (size_t)(tok - NPTOK) * DM; }

#define PG8_LAS __attribute__((address_space(3)))
namespace pg8 {
constexpr int BM = 256, BK = 64, HALF = 128, HTB = HALF * BK * 2, STAGE_BYTES = 8 * HTB, NXCD = 8, WGM = 3;
DI int lds_byte(int r, int c) { const int st = (r >> 4) * 2 + (c >> 5), rr = r & 15, cc = c & 31, ob = rr * 64 + cc * 2; return st * 1024 + (ob ^ (((ob >> 9) & 1) << 5)); }
DI void stage_rc(int b, int& R, int& C) { const int st = b / 1024, sb = b % 1024, swz = sb ^ (((sb >> 9) & 1) << 5); R = (st >> 1) * 16 + swz / 64; C = (st & 1) * 32 + (swz % 64) / 2; }
DI int perm32(int rho) { const int n = rho >> 4, i = rho & 15; return 8 * (i >> 2) + 4 * n + (i & 3); }
struct Unit { int pm, pn, z; };
struct Gemm { const bf16_t* A; const bf16_t* Bt; long az, bz; int lda, ldb, M, N, K, Z; };
struct Order {
    int nM, nN, nwg, total, G, c, Z;
    DI void init(int M, int N, int Z_, int G_, int c_) { nM = M / BM; nN = N / BM; nwg = nM * nN; Z = Z_; total = nwg * Z_; G = G_; c = c_; }
    DI bool next(int i, Unit& u) const {
        const int L = i * G + c; if (L >= total) return false;
        if (Z == 1) {
            int wgid = L; { const int q = nwg / NXCD, r = nwg % NXCD, xcd = wgid % NXCD, off = wgid / NXCD; wgid = (xcd < r ? xcd * (q + 1) : r * (q + 1) + (xcd - r) * q) + off; }
            const int nig = WGM * nN, gid = wgid / nig, fm = gid * WGM, gsz = (nM - fm) < WGM ? (nM - fm) : WGM;
            u.pm = fm + ((wgid % nig) % gsz); u.pn = (wgid % nig) / gsz; u.z = 0;
        } else { const int z = (int)((unsigned)L / (unsigned)nwg), r = L - z * nwg; u.z = z; u.pm = r % nM; u.pn = r / nM; }
        return true;
    }
    DI void a_ready(const Unit&) const {}
    DI void done(const Unit&) const {}
};
template <class F> struct Epi {
    static constexpr bool PERM = true, AFTER_DRAIN = false;
    F f;
    DI void operator()(const f32x4 (&acc)[2][2][4][2], const Unit& u, int wr, int wc, int fr, int fq) const {
#pragma unroll
        for (int ai = 0; ai < 2; ++ai)
#pragma unroll
            for (int m = 0; m < 4; ++m) {
                const int row = u.pm * BM + ai * HALF + wr * 64 + m * 16 + fr;
#pragma unroll
                for (int bj = 0; bj < 2; ++bj) f(u.z, row, u.pn * BM + bj * HALF + wc * 32 + 8 * fq, acc[ai][bj][m][0], acc[ai][bj][m][1]);
                asm volatile("" ::: "memory");
            }
    }
};
template <class EpiT, class Sched, bool ALIGN_EPI = true>
DI void gemm_phase(PG8_LAS unsigned char* lds, const Gemm g, const Sched& S, const EpiT& E) {
    const int tid = threadIdx.x, wid = __builtin_amdgcn_readfirstlane(tid >> 6), lane = tid & 63, wr = wid >> 2, wc = wid & 3, fr = lane & 15, fq = lane >> 4;
    const int K = g.K, nt = K / BK;
    unsigned voffA, voffB;
    { int R, C; stage_rc(tid * 16, R, C); const int Rb = EpiT::PERM ? ((R & ~31) + perm32(R & 31)) : R; voffA = (unsigned)(R * g.lda + C) * 2u; voffB = (unsigned)(Rb * g.ldb + C) * 2u; }
    const size_t r64voffA = (size_t)64 * g.lda * 2, r64voffB = (size_t)64 * g.ldb * 2;
    const size_t kstep = (size_t)(BK * 2);
    const size_t hstepA = (size_t)HALF * g.lda * 2, hstepB = (size_t)HALF * g.ldb * 2;
    const size_t tstepA = 2 * hstepA, tstepB = 2 * hstepB;
    const unsigned ldsw = (unsigned)wid * 1024u;
    const int aoff = lds_byte(wr * 64 + fr, fq * 8), boff = lds_byte(wc * 32 + fr, fq * 8);
#define PG8_SA(b, h) (((b) * 2 + (h)) * HTB)
#define PG8_SB(b, h) ((4 + (b) * 2 + (h)) * HTB)
#define PG8_STAGE(bufoff, gbase, voff) do { \
        __builtin_amdgcn_global_load_lds((const unsigned*)((const char*)(gbase) + (voff)), (PG8_LAS unsigned*)(lds + (bufoff) + ldsw), 16, 0, 0); \
        __builtin_amdgcn_global_load_lds((const unsigned*)((const char*)(gbase) + r64##voff + (voff)), (PG8_LAS unsigned*)(lds + (bufoff) + ldsw + 8192), 16, 0, 0); } while (0)
#define PG8_LDA(dst, b, h) do { _Pragma("unroll") for (int m = 0; m < 4; ++m) _Pragma("unroll") for (int k = 0; k < 2; ++k) dst[m][k] = *(const PG8_LAS bf16x8*)(lds + PG8_SA(b, h) + aoff + m * 2048 + k * 1024); } while (0)
#define PG8_LDB(dst, b, h) do { _Pragma("unroll") for (int n = 0; n < 2; ++n) _Pragma("unroll") for (int k = 0; k < 2; ++k) dst[n][k] = *(const PG8_LAS bf16x8*)(lds + PG8_SB(b, h) + boff + n * 2048 + k * 1024); } while (0)
#define PG8_MMA(ai, bj, At, Bt) do { __builtin_amdgcn_s_setprio(1); _Pragma("unroll") for (int m = 0; m < 4; ++m) _Pragma("unroll") for (int n = 0; n < 2; ++n) _Pragma("unroll") for (int k = 0; k < 2; ++k) \
        acc[ai][bj][m][n] = __builtin_amdgcn_mfma_f32_16x16x32_bf16(Bt[n][k], At[m][k], acc[ai][bj][m][n], 0, 0, 0); __builtin_amdgcn_s_setprio(0); } while (0)
#define PG8_WAIT_V(n) asm volatile("s_waitcnt vmcnt(" #n ")" ::: "memory")
#define PG8_WAIT_L(n) asm volatile("s_waitcnt lgkmcnt(" #n ")" ::: "memory")
#define PG8_BAR __builtin_amdgcn_s_barrier()
#define PG8_SCHED __builtin_amdgcn_sched_barrier(0)
    Unit cur, nxt; int ui = 0;
    if (!S.next(0, cur)) return;
    f32x4 acc[2][2][4][2];
#pragma unroll
    for (int a = 0; a < 2; ++a)
#pragma unroll
        for (int b = 0; b < 2; ++b)
#pragma unroll
            for (int m = 0; m < 4; ++m)
#pragma unroll
                for (int n = 0; n < 2; ++n) acc[a][b][m][n] = (f32x4){0.f, 0.f, 0.f, 0.f};
    bf16x8 At[4][2], B0[2][2], B1[2][2];
    const char* cA = (const char*)g.A + (size_t)cur.z * g.az * 2 + (size_t)cur.pm * tstepA; const char* cB = (const char*)g.Bt + (size_t)cur.z * g.bz * 2 + (size_t)cur.pn * tstepB;
    S.a_ready(cur);
    PG8_STAGE(PG8_SB(0, 0), cB, voffB); PG8_STAGE(PG8_SB(0, 1), cB + hstepB, voffB); PG8_STAGE(PG8_SA(0, 0), cA, voffA); PG8_STAGE(PG8_SA(0, 1), cA + hstepA, voffA);
    if (wr == 1) PG8_BAR;
    PG8_WAIT_V(2); PG8_BAR;
    PG8_STAGE(PG8_SB(1, 0), cB + kstep, voffB); PG8_STAGE(PG8_SA(1, 0), cA + kstep, voffA); PG8_STAGE(PG8_SB(1, 1), cB + hstepB + kstep, voffB);
    PG8_WAIT_V(6); PG8_BAR;
    for (;;) {
        const bool has_next = S.next(ui + 1, nxt);
        const char* nA = has_next ? (const char*)g.A + (size_t)nxt.z * g.az * 2 + (size_t)nxt.pm * tstepA : cA; const char* nB = has_next ? (const char*)g.Bt + (size_t)nxt.z * g.bz * 2 + (size_t)nxt.pn * tstepB : cB;
#pragma unroll 1
        for (int t = 0; t < nt; t += 2) {
            const bool last = (t == nt - 2);
            const char* a1 = cA + (size_t)(t + 1) * kstep;
            const char* a2 = last ? nA : cA + (size_t)(t + 2) * kstep; const char* b2 = last ? nB : cB + (size_t)(t + 2) * kstep;
            const char* a3 = a2 + kstep; const char* b3 = b2 + kstep;
            if (last && has_next) S.a_ready(nxt);
            PG8_LDB(B0, 0, 0); PG8_LDB(B1, 0, 1); PG8_SCHED; PG8_LDA(At, 0, 0); PG8_STAGE(PG8_SA(1, 1), a1 + hstepA, voffA);
            PG8_WAIT_V(8); PG8_WAIT_L(0); PG8_BAR; PG8_MMA(0, 0, At, B0); PG8_MMA(0, 1, At, B1); PG8_BAR; PG8_SCHED;
            PG8_LDA(At, 0, 1); PG8_STAGE(PG8_SB(0, 0), b2, voffB); PG8_STAGE(PG8_SB(0, 1), b2 + hstepB, voffB); PG8_STAGE(PG8_SA(0, 0), a2, voffA);
            PG8_WAIT_V(8); PG8_WAIT_L(0); PG8_BAR; PG8_MMA(1, 0, At, B0); PG8_MMA(1, 1, At, B1); PG8_BAR; PG8_SCHED;
            PG8_LDB(B0, 1, 0); PG8_LDB(B1, 1, 1); PG8_SCHED; PG8_LDA(At, 1, 0); PG8_STAGE(PG8_SA(0, 1), a2 + hstepA, voffA);
            PG8_WAIT_V(8); PG8_WAIT_L(0); PG8_BAR; PG8_MMA(0, 0, At, B0); PG8_MMA(0, 1, At, B1); PG8_BAR; PG8_SCHED;
            PG8_LDA(At, 1, 1); PG8_STAGE(PG8_SB(1, 0), b3, voffB); PG8_STAGE(PG8_SB(1, 1), b3 + hstepB, voffB); PG8_STAGE(PG8_SA(1, 0), a3, voffA);
            PG8_WAIT_V(8); PG8_WAIT_L(0); PG8_BAR; PG8_MMA(1, 0, At, B0); PG8_MMA(1, 1, At, B1); PG8_BAR; PG8_SCHED;
        }
        if constexpr (ALIGN_EPI) { if (wr == 0) PG8_BAR; }
        E(acc, cur, wr, wc, fr, fq); S.done(cur);
        if (!has_next) break;
#pragma unroll
        for (int a = 0; a < 2; ++a)
#pragma unroll
            for (int b = 0; b < 2; ++b)
#pragma unroll
                for (int m = 0; m < 4; ++m)
#pragma unroll
                    for (int n = 0; n < 2; ++n) acc[a][b][m][n] = (f32x4){0.f, 0.f, 0.f, 0.f};
        cur = nxt; cA = nA; cB = nB; ++ui;
        if constexpr (ALIGN_EPI) { if (wr == 1) PG8_BAR; }
    }
    PG8_WAIT_V(0);
    if constexpr (!ALIGN_EPI) { if (wr == 0) PG8_BAR; }
    PG8_BAR;
#undef PG8_SA
#undef PG8_SB
#undef PG8_STAGE
#undef PG8_LDA
#undef PG8_LDB
#undef PG8_MMA
#undef PG8_WAIT_V
#undef PG8_WAIT_L
#undef PG8_BAR
#undef PG8_SCHED
}
}
typedef pg8::Gemm GemmDesc;
template <class F>
DI void gemm_run(const GemmDesc g, const F f, PG8_LAS unsigned char* lds, int wg0 = 0, int nwg = 0) {
    if (nwg == 0) nwg = (int)gridDim.x;
    const int c = (int)blockIdx.x - wg0;
    pg8::Order S; S.init(g.M, g.N, g.Z, nwg, c);
    if (c < 0 || c >= nwg) { S.total = 0; S.c = 0; }
    const pg8::Epi<F> E{f};
    pg8::gemm_phase<pg8::Epi<F>, pg8::Order, true>(lds, g, S, E);
    __syncthreads();
}

DI u32x4 pk8(f32x4 a, f32x4 b) { u32x4 r; r.x = pk2(a[0], a[1]); r.y = pk2(a[2], a[3]); r.z = pk2(b[0], b[1]); r.w = pk2(b[2], b[3]); return r; }
DI void unpk8(u32x4 r, f32x4& a, f32x4& b) { a = unpk4((u32x2){r.x, r.y}); b = unpk4((u32x2){r.z, r.w}); }
DI int qk_perm(int c) { const int c6 = c & 63; return (c & ~63) + 32 * ((c6 >> 2) & 1) + 4 * (c6 >> 3) + (c6 & 3); }
struct EpiInE {
    bf16_t *ucomb, *yab, *q, *kP, *kS, *vTP, *vTS; float* out; const float *rc, *rs;
    DI void operator()(int, int m, int n, f32x4 lo, f32x4 hi) const {
        const int seg = n >> 10, nn = n & 1023;
        const bool samp = m >= NPTOK;
        if (seg == 0) {
            const int chunk = m >> 4, t = m & 15, g = nn >> 4, mm = nn & 15;
            *(u32x4*)(ucomb + ((size_t)(g * 768 + chunk) * 512 + t * 16 + mm)) = pk8(lo, hi);
        } else if (seg == 1 || seg == 5) {
            f32x4 a, b;
#pragma unroll
            for (int e = 0; e < 4; ++e) { a[e] = siluf(lo[e]); b[e] = siluf(hi[e]); }
            *(u32x4*)(yab + (size_t)m * 2048 + (seg == 5 ? 1024 : 0) + nn) = pk8(a, b);
        } else if (seg == 2 || seg == 3) {
            const int j0 = (nn & 63) >> 1, ft = (nn & ~63) + j0;
            if (!samp && seg == 3) { float* o = out + OUT_CK + (size_t)m * 1024 + ft; *(f32x4*)o = lo; *(f32x4*)(o + 32) = hi; }
            if (samp) {
                const int pos = (m - NPTOK) & 1023;
                const f32x4 cs = *(const f32x4*)(rc + pos * 32 + j0), sn = *(const f32x4*)(rs + pos * 32 + j0);
                const f32x4 a = lo * cs - hi * sn, b = lo * sn + hi * cs; lo = a; hi = b;
            }
            if (seg == 2) { lo = lo * 0.125f; hi = hi * 0.125f; bf16_t* dst = q + (size_t)m * 1024 + ft; *(u32x2*)dst = pk4(lo); *(u32x2*)(dst + 32) = pk4(hi); }
            else {
                bf16_t* dst;
                if (!samp) dst = kP + (size_t)m * 1024 + ft;
                else { const int b = (m - NPTOK) >> 10, pos = (m - NPTOK) & 1023; dst = kS + ((size_t)(b * 1280 + 256 + pos)) * 1024 + ft; }
                *(u32x2*)dst = pk4(lo); *(u32x2*)(dst + 32) = pk4(hi);
            }
        } else {
            if (!samp) {
                float* o = out + OUT_CV + (size_t)m * 1024 + nn; *(f32x4*)o = lo; *(f32x4*)(o + 4) = hi;
                const int b = m >> 8, pos = m & 255;
                bf16_t* dst = vTP + ((size_t)(b * 1024 + nn)) * 256 + pos;
#pragma unroll
                for (int e = 0; e < 4; ++e) { dst[(size_t)e * 256] = f2bf(lo[e]); dst[(size_t)(e + 4) * 256] = f2bf(hi[e]); }
            } else {
                const int b = (m - NPTOK) >> 10, pos = (m - NPTOK) & 1023;
                bf16_t* dst = vTS + ((size_t)(b * 1024 + nn)) * 1280 + 256 + pos;
#pragma unroll
                for (int e = 0; e < 4; ++e) { dst[(size_t)e * 1280] = f2bf(lo[e]); dst[(size_t)(e + 4) * 1280] = f2bf(hi[e]); }
            }
        }
    }
};
struct EpiS {
    float* S;
    DI void operator()(int z, int m, int n, f32x4 lo, f32x4 hi) const { float* o = S + ((size_t)(z * 768 + m)) * 256 + n; *(f32x4*)o = lo; *(f32x4*)(o + 4) = hi; }
};
struct EpiY {
    bf16_t* ga;
    DI void operator()(int z, int m, int n, f32x4 lo, f32x4 hi) const {
        f32x4 a, b;
#pragma unroll
        for (int e = 0; e < 4; ++e) { a[e] = gelu_tanh(lo[e]); b[e] = gelu_tanh(hi[e]); }
        const int t = n >> 4, nn = n & 15;
        *(u32x4*)(ga + ((size_t)(m * 16 + t)) * 1024 + z * 16 + nn) = pk8(a, b);
    }
};
struct EpiGlu {
    const bf16_t* ga; bf16_t* yab; const float* bglu;
    DI void operator()(int, int m, int n, f32x4 lo, f32x4 hi) const {
        const f32x4 b0 = *(const f32x4*)(bglu + n), b1 = *(const f32x4*)(bglu + n + 4);
        f32x4 g0, g1, s0, s1;
        unpk8(*(const u32x4*)(ga + (size_t)m * 1024 + n), g0, g1);
        bf16_t* dst = yab + (size_t)m * 2048 + n;
        unpk8(*(const u32x4*)dst, s0, s1);
        f32x4 o0, o1;
#pragma unroll
        for (int e = 0; e < 4; ++e) { o0[e] = g0[e] * s0[e] / (1.f + __expf(-(lo[e] + b0[e]))); o1[e] = g1[e] * s1[e] / (1.f + __expf(-(hi[e] + b1[e]))); }
        *(u32x4*)dst = pk8(o0, o1);
    }
};
struct EpiRes {
    const float *xa, *xb; int split; const float* gate; bf16_t* zp;
    DI void operator()(int, int m, int n, f32x4 lo, f32x4 hi) const {
        const float* xr = m < split ? xa + (size_t)m * 1024 + n : xb + (size_t)(m - split) * 1024 + n;
        const float* gp = gate + cond_of(m) * 3072 + 2048 + n;
        const f32x4 x0 = *(const f32x4*)xr, x1 = *(const f32x4*)(xr + 4), g0 = *(const f32x4*)gp, g1 = *(const f32x4*)(gp + 4);
        *(u32x4*)(zp + (size_t)m * 1024 + n) = pk8(x0 * ALPHA + g0 * lo, x1 * ALPHA + g1 * hi);
    }
};
struct EpiInO {
    bf16_t *uo, *zo;
    DI void operator()(int, int m, int n, f32x4 lo, f32x4 hi) const {
        if (n < 2048) *(u32x4*)(uo + (size_t)m * 2048 + n) = pk8(lo, hi);
        else {
            f32x4 a, b;
#pragma unroll
            for (int e = 0; e < 4; ++e) { a[e] = siluf(lo[e]); b[e] = siluf(hi[e]); }
            *(u32x4*)(zo + (size_t)m * 2048 + (n - 2048)) = pk8(a, b);
        }
    }
};
struct EpiDftA {
    bf16_t *Tp, *Ts;
    DI void operator()(int z, int m, int n, f32x4 lo, f32x4 hi) const {
        const int cs = m >> 8, j = m & 255;
        const bool pr = n < NPTOK;
        const int sh = pr ? 8 : 10, nn = pr ? n : n - NPTOK, L = 1 << sh, bb = nn >> sh, l = nn & (L - 1);
        *(u32x4*)((pr ? Tp : Ts) + (unsigned)(((bb * 2048 + z * 256 + j) << (sh + 1)) + (cs << sh) + l)) = pk8(lo, hi);
    }
};
struct EpiDftB {
    bf16_t* mixed; int tok0, L;
    DI void operator()(int z, int m, int n, f32x4 lo, f32x4 hi) const { *(u32x4*)(mixed + ((size_t)(tok0 + z * L + m)) * 2048 + n) = pk8(lo, hi); }
};
struct EpiFno {
    const bf16_t* zo; bf16_t* y; const float* bias;
    DI void operator()(int, int m, int n, f32x4 lo, f32x4 hi) const {
        const f32x4 b0 = *(const f32x4*)(bias + n), b1 = *(const f32x4*)(bias + n + 4);
        f32x4 s0, s1; unpk8(*(const u32x4*)(zo + (size_t)m * 2048 + n), s0, s1);
        *(u32x4*)(y + (size_t)m * 2048 + n) = pk8((lo + b0) * s0, (hi + b1) * s1);
    }
};

DI void convert_wt(const float* W, bf16_t* Wt, int K, int N, char* smem, int rot, int p0, int p1) {
    const int half = threadIdx.x >> 8, tid = threadIdx.x & 255;
    float* tile = (float*)(smem + half * 16896);
    const int tn = N / 64, total = (K / 64) * tn, G = gridDim.x;
    int bid = (int)blockIdx.x - rot; bid %= G; if (bid < 0) bid += G;
    for (int t0 = bid * 2; t0 < total; t0 += G * 2) {
        const int t = t0 + half; const bool ok = t < total;
        const int k0 = (t / tn) * 64, n0 = (t % tn) * 64;
        __syncthreads();
        if (ok) { const int r = tid >> 4, c4 = (tid & 15) * 4;
#pragma unroll
          for (int i = 0; i < 4; ++i) { const f32x4 v = *(const f32x4*)(W + (size_t)(k0 + r + 16 * i) * N + n0 + c4);
              float* d = tile + (r + 16 * i) * 65 + c4; d[0] = v[0]; d[1] = v[1]; d[2] = v[2]; d[3] = v[3]; } }
        __syncthreads();
        if (ok) { const int n = tid >> 2, kq = (tid & 3) * 16; u32x4 w0, w1;
          const int rown = n0 + n, src = (rown >= p0 && rown < p1) ? (qk_perm(rown) - n0) : n;
          const float* s = tile + src;
          w0.x = pk2(s[(kq + 0) * 65], s[(kq + 1) * 65]); w0.y = pk2(s[(kq + 2) * 65], s[(kq + 3) * 65]); w0.z = pk2(s[(kq + 4) * 65], s[(kq + 5) * 65]); w0.w = pk2(s[(kq + 6) * 65], s[(kq + 7) * 65]);
          w1.x = pk2(s[(kq + 8) * 65], s[(kq + 9) * 65]); w1.y = pk2(s[(kq + 10) * 65], s[(kq + 11) * 65]); w1.z = pk2(s[(kq + 12) * 65], s[(kq + 13) * 65]); w1.w = pk2(s[(kq + 14) * 65], s[(kq + 15) * 65]);
          bf16_t* d = Wt + (size_t)rown * K + k0 + kq; *(u32x4*)d = w0; *(u32x4*)(d + 8) = w1; }
    }
    __syncthreads();
}

DI void convert_wt_sub(const float* W, bf16_t* Wt, int K, int N, char* smem, int bid, int G, int ldt = 0) {
    const int p0 = 0, p1 = 0;
    const int half = threadIdx.x >> 8, tid = threadIdx.x & 255;
    float* tile = (float*)(smem + half * 16896);
    const int tn = N / 64, total = (K / 64) * tn;
    for (int t0 = bid * 2; t0 < total; t0 += G * 2) {
        const int t = t0 + half; const bool ok = t < total;
        const int k0 = (t / tn) * 64, n0 = (t % tn) * 64;
        __syncthreads();
        if (ok) { const int r = tid >> 4, c4 = (tid & 15) * 4;
#pragma unroll
          for (int i = 0; i < 4; ++i) { const f32x4 v = *(const f32x4*)(W + (size_t)(k0 + r + 16 * i) * N + n0 + c4);
              float* d = tile + (r + 16 * i) * 65 + c4; d[0] = v[0]; d[1] = v[1]; d[2] = v[2]; d[3] = v[3]; } }
        __syncthreads();
        if (ok) { const int n = tid >> 2, kq = (tid & 3) * 16; u32x4 w0, w1;
          const int rown = n0 + n, src = (rown >= p0 && rown < p1) ? (qk_perm(rown) - n0) : n;
          const float* s = tile + src;
          w0.x = pk2(s[(kq + 0) * 65], s[(kq + 1) * 65]); w0.y = pk2(s[(kq + 2) * 65], s[(kq + 3) * 65]); w0.z = pk2(s[(kq + 4) * 65], s[(kq + 5) * 65]); w0.w = pk2(s[(kq + 6) * 65], s[(kq + 7) * 65]);
          w1.x = pk2(s[(kq + 8) * 65], s[(kq + 9) * 65]); w1.y = pk2(s[(kq + 10) * 65], s[(kq + 11) * 65]); w1.z = pk2(s[(kq + 12) * 65], s[(kq + 13) * 65]); w1.w = pk2(s[(kq + 14) * 65], s[(kq + 15) * 65]);
          bf16_t* d = Wt + (size_t)rown * (ldt ? ldt : K) + k0 + kq; *(u32x4*)d = w0; *(u32x4*)(d + 8) = w1; }
    }
    __syncthreads();
}

DI void ssm_params(const Params& p, char* smem, int bid, int nb) {
    const int half = threadIdx.x >> 8, tid = threadIdx.x & 255;
    f32x2* apow = (f32x2*)(smem + half * 51200);
    f32x2* Bb = apow + 2 * 17 * 64;
    f32x2* Cc = Bb + 2 * 64 * 16;
    bf16_t* WS = (bf16_t*)(p.ws + OFF_WS);
    bf16_t* WY = (bf16_t*)(p.ws + OFF_WY);
    for (int j0 = bid * 2; j0 < 128; j0 += nb * 2) {
        const int job = j0 + half, g = job >> 1, dsel = job & 1;
        __syncthreads();
        {
            const int d = tid >> 7, pp = (tid >> 1) & 63, th = tid & 1;
            const float lr = p.lam_re[(d * 64 + g) * 64 + pp], li = p.lam_im[(d * 64 + g) * 64 + pp], dt = expf(p.log_dt[d * 64 + g]);
#pragma unroll 1
            for (int tau = th; tau <= 16; tau += 2) { const float mag = expf(lr * dt * (float)tau); float s, c; sincosf(li * dt * (float)tau, &s, &c); apow[(d * 17 + tau) * 64 + pp] = (f32x2){mag * c, mag * s}; }
            float s1, c1, sh, chh; sincosf(li * dt, &s1, &c1); sincosf(0.5f * li * dt, &sh, &chh);
            const float em1 = expm1f(lr * dt), mag = em1 + 1.f;
            const float arm1 = em1 * c1 - 2.f * sh * sh, ai = mag * s1;
            const float den = lr * lr + li * li;
            const float fr = (arm1 * lr + ai * li) / den, fi = (ai * lr - arm1 * li) / den;
#pragma unroll 1
            for (int m = th * 8; m < th * 8 + 8; ++m) { const float br = p.b_re[((d * 64 + g) * 64 + pp) * 16 + m], bi = p.b_im[((d * 64 + g) * 64 + pp) * 16 + m];
                Bb[(d * 64 + pp) * 16 + m] = (f32x2){fr * br - fi * bi, fr * bi + fi * br}; }
        }
        for (int i = tid; i < 2048; i += 256) { const int d = i >> 10, n = (i >> 6) & 15, pp = i & 63; const size_t gi = ((size_t)(d * 64 + g) * 16 + n) * 64 + pp; Cc[i] = (f32x2){p.c_re[gi], p.c_im[gi]}; }
        __syncthreads();
        bf16_t* wy = WY + (size_t)g * 256 * 512;
        bf16_t* wsg = WS + (size_t)g * 256 * 256;
        {
            const int n = tid >> 4, m = tid & 15, d = dsel;
            float kk[16];
#pragma unroll
            for (int t = 0; t < 16; ++t) kk[t] = 0.f;
            float ko = 0.f;
#pragma unroll 1
            for (int pp = 0; pp < 64; ++pp) {
                const f32x2 cv = Cc[(d * 16 + n) * 64 + pp], bv = Bb[(d * 64 + pp) * 16 + m];
                const float cbr = cv.x * bv.x - cv.y * bv.y, cbi = cv.x * bv.y + cv.y * bv.x;
#pragma unroll
                for (int t = 0; t < 16; ++t) { const f32x2 a = apow[(d * 17 + t) * 64 + pp]; kk[t] += cbr * a.x - cbi * a.y; }
                const f32x2 co = Cc[((d ^ 1) * 16 + n) * 64 + pp], bo = Bb[((d ^ 1) * 64 + pp) * 16 + m];
                ko += co.x * bo.x - co.y * bo.y;
            }
            if (d == 0) {
#pragma unroll
                for (int tau = 1; tau < 16; ++tau) { const bf16_t v = f2bf(kk[tau]);
#pragma unroll 1
                    for (int t = tau; t < 16; ++t) wy[(size_t)(t * 16 + n) * 512 + (t - tau) * 16 + m] = v; }
            } else {
                const bf16_t dv = f2bf(ko + kk[0] + (n == m ? p.ssm_d[g * 16 + n] : 0.f));
#pragma unroll 1
                for (int t = 0; t < 16; ++t) wy[(size_t)(t * 16 + n) * 512 + t * 16 + m] = dv;
#pragma unroll
                for (int tau = 1; tau < 16; ++tau) { const bf16_t v = f2bf(kk[tau]);
#pragma unroll 1
                    for (int t = 0; t + tau < 16; ++t) wy[(size_t)(t * 16 + n) * 512 + (t + tau) * 16 + m] = v; }
            }
        }
        {
            const int d = dsel, c7 = tid & 127, ri = c7 >> 6, pp = c7 & 63, hx = tid >> 7, cidx = d * 128 + c7;
#pragma unroll 1
            for (int row = hx * 128; row < hx * 128 + 128; ++row) {
                const int t = row >> 4, n = row & 15, e = d == 0 ? t + 1 : 16 - t;
                const f32x2 cv = Cc[(d * 16 + n) * 64 + pp], a = apow[(d * 17 + e) * 64 + pp];
                const float v = ri == 0 ? (cv.x * a.x - cv.y * a.y) : -(cv.x * a.y + cv.y * a.x);
                wy[(size_t)row * 512 + 256 + cidx] = f2bf(v);
            }
#pragma unroll 1
            for (int s = hx * 8; s < hx * 8 + 8; ++s) {
                const int e = d == 0 ? 15 - s : s;
                const f32x2 a = apow[(d * 17 + e) * 64 + pp];
                float v[16];
#pragma unroll
                for (int m = 0; m < 16; ++m) { const f32x2 bv = Bb[(d * 64 + pp) * 16 + m]; v[m] = ri == 0 ? (a.x * bv.x - a.y * bv.y) : (a.x * bv.y + a.y * bv.x); }
                u32x4 w0, w1;
                w0.x = pk2(v[0], v[1]); w0.y = pk2(v[2], v[3]); w0.z = pk2(v[4], v[5]); w0.w = pk2(v[6], v[7]);
                w1.x = pk2(v[8], v[9]); w1.y = pk2(v[10], v[11]); w1.z = pk2(v[12], v[13]); w1.w = pk2(v[14], v[15]);
                bf16_t* dd = wsg + (size_t)cidx * 256 + s * 16; *(u32x4*)dd = w0; *(u32x4*)(dd + 8) = w1;
            }
        }
    }
    __syncthreads();
}

DI void mod_gemv(const Params& p, char* smem, int rot) {
    float* sc = (float*)smem;
    float* red = sc + 5 * 1024;
    float* modv = (float*)(p.ws + OFF_MOD);
    const int tid = threadIdx.x;
    int bid = (int)blockIdx.x - rot; bid %= (int)gridDim.x; if (bid < 0) bid += gridDim.x;
    if (bid >= 192) return;
    __syncthreads();
    for (int i = tid; i < 5 * 1024; i += 512) { const int ci = i >> 10, k = i & 1023; const float v = ci == 0 ? p.c_ctx[k] : p.c[(ci - 1) * 1024 + k]; sc[i] = siluf(v); }
    __syncthreads();
    for (int u = bid; u < 192; u += gridDim.x) {
        const int l = u / 96, c0 = (u % 96) * 32, col = tid & 31, ks = tid >> 5;
        const float* w = p.w_mod + (size_t)l * 1024 * 3072 + c0 + col;
        float a0 = 0.f, a1 = 0.f, a2 = 0.f, a3 = 0.f, a4 = 0.f;
#pragma unroll 16
        for (int k = ks * 64; k < ks * 64 + 64; ++k) { const float wv = w[(size_t)k * 3072]; a0 += wv * sc[k]; a1 += wv * sc[1024 + k]; a2 += wv * sc[2048 + k]; a3 += wv * sc[3072 + k]; a4 += wv * sc[4096 + k]; }
        float* r = red + (ks * 32 + col) * 5; r[0] = a0; r[1] = a1; r[2] = a2; r[3] = a3; r[4] = a4;
        __syncthreads();
        if (tid < 160) { const int ci = tid >> 5, cc = tid & 31; float s = p.b_mod[l * 3072 + c0 + cc];
#pragma unroll
            for (int q = 0; q < 16; ++q) s += red[(q * 32 + cc) * 5 + ci];
            modv[(l * 5 + ci) * 3072 + c0 + cc] = s; }
        __syncthreads();
    }
}

DI void phase_prep(const Params& p, char* smem) {
    const int tid = threadIdx.x, G = gridDim.x;
    const size_t gt = (size_t)blockIdx.x * 512 + tid, gn = (size_t)G * 512;
    mod_gemv(p, smem, 64);
    convert_wt(p.w_in_e, (bf16_t*)(p.ws + OFF_WINE), 1024, 6144, smem, 0, 2048, 4096);
    { float* rc = (float*)(p.ws + OFF_ROPEC); float* rs = (float*)(p.ws + OFF_ROPES);
      for (size_t i = gt; i < 1024 * 32; i += gn) { const int pos = i >> 5, j = i & 31; const float fq = exp2f(-(float)(j & 15) * (13.287712379549449f / 16.f));
          const float ang = (float)(j < 16 ? (pos >> 6) : (pos & 63)) * fq; float s, c; sincosf(ang, &s, &c); rc[i] = c; rs[i] = s; } }
}
DI void phase_prep_late(const Params& p, char* smem, int bid, int nb) {
    const int tid = threadIdx.x;
    ssm_params(p, smem, bid, nb);
    if (bid < 64) return;
    const size_t gt = (size_t)(bid - 64) * 512 + tid, gn = (size_t)(nb - 64) * 512;
    if (bid == nb - 1 && tid < 64) {
        const float a = wave_sum(p.lq1[tid] * p.lk1[tid]), b = wave_sum(p.lq2[tid] * p.lk2[tid]);
        if (tid == 0) *(float*)(p.ws + OFF_LAM) = expf(a) - expf(b) + LAM_INIT;
    }
    { bf16_t* kS = (bf16_t*)(p.ws + OFF_KS);
      for (size_t i = gt; i < (size_t)4 * 256 * 256; i += gn) {
          const int b = i >> 16, r = i & 65535, pos = r >> 8, c4 = (r & 255) * 4;
          const f32x4 v = *(const f32x4*)(p.cache_k + ((size_t)(b * 256 + pos)) * 1024 + c4);
          *(u32x2*)(kS + ((size_t)(b * 1280 + pos)) * 1024 + c4) = pk4(v); } }
    for (int b = 0; b < 4; ++b)
        convert_wt_sub(p.cache_v + (size_t)b * 256 * 1024, (bf16_t*)(p.ws + OFF_VTS) + (size_t)b * 1024 * 1280, 256, 1024, smem, bid - 64, nb - 64, 1280);
}

DI void phase_prep_later(const Params& p, char* smem, int bid, int nb) {
    const int tid = threadIdx.x;
    const size_t gt = (size_t)bid * 512 + tid, gn = (size_t)nb * 512;
    convert_wt_sub(p.w_out_e, (bf16_t*)(p.ws + OFF_WOUTE), 2048, 1024, smem, bid, nb);
    { bf16_t* W = (bf16_t*)(p.ws + OFF_WDFT);
      for (size_t i = gt; i < 512 * 256; i += gn) { const int c = i & 255, j = (i >> 8) & 255, cs = i >> 16; const float x = 2.f * (float)((j * c) & 255) / 256.f; W[i] = f2bf((cs ? sinpif(x) : cospif(x)) * 0.0625f); } }
    { bf16_t* W = (bf16_t*)(p.ws + OFF_DL256);
      for (size_t i = gt; i < 256 * 512; i += gn) { const int col = i & 511, k = i >> 9, cs = col >> 8, l = col & 255; const float x = 2.f * (float)((k * l) & 255) / 256.f; W[i] = f2bf((cs ? -sinpif(x) : cospif(x)) * 0.0625f); } }
    { bf16_t* W = (bf16_t*)(p.ws + OFF_DL1K);
      for (size_t i = gt; i < 1024 * 2048; i += gn) { const int col = i & 2047, k = i >> 11, cs = col >> 10, l = col & 1023; const float x = 2.f * (float)((k * l) & 1023) / 1024.f; W[i] = f2bf((cs ? -sinpif(x) : cospif(x)) * 0.03125f); } }
}

DI void phase_ln0(const Params& p) {
    const int lane = threadIdx.x & 63, wid = threadIdx.x >> 6;
    const float* modv = (const float*)(p.ws + OFF_MOD);
    bf16_t* h = (bf16_t*)(p.ws + OFF_H0);
    const int stride = gridDim.x * 8;
    f32x4 nv[4];
    { const float* xr = xin(p, blockIdx.x * 8 + wid);
#pragma unroll
      for (int i = 0; i < 4; ++i) nv[i] = *(const f32x4*)(xr + i * 256 + lane * 4); }
    for (int tok = blockIdx.x * 8 + wid; tok < NTOK; tok += stride) {
        f32x4 v[4]; float s = 0.f;
#pragma unroll
        for (int i = 0; i < 4; ++i) v[i] = nv[i];
        if (tok + stride < NTOK) {
            const float* xr = xin(p, tok + stride);
#pragma unroll
            for (int i = 0; i < 4; ++i) nv[i] = *(const f32x4*)(xr + i * 256 + lane * 4);
        }
#pragma unroll
        for (int i = 0; i < 4; ++i) s += v[i][0] + v[i][1] + v[i][2] + v[i][3];
        const float mu = wave_sum(s) * (1.f / 1024.f);
        float q = 0.f;
#pragma unroll
        for (int i = 0; i < 4; ++i) { v[i] = v[i] - mu; q += v[i][0] * v[i][0] + v[i][1] * v[i][1] + v[i][2] * v[i][2] + v[i][3] * v[i][3]; }
        const float rstd = rsqrtf(wave_sum(q) * (1.f / 1024.f) + LN_EPS);
        const float* md = modv + (0 * 5 + cond_of(tok)) * 3072;
#pragma unroll
        for (int i = 0; i < 4; ++i) { const int c = i * 256 + lane * 4; const f32x4 sh = *(const f32x4*)(md + c), sc = *(const f32x4*)(md + 1024 + c);
            *(u32x2*)(h + (size_t)tok * 1024 + c) = pk4(v[i] * rstd * (sc + 1.f) + sh); }
    }
}
DI void phase_ln_mid(const Params& p) {
    const int lane = threadIdx.x & 63, wid = threadIdx.x >> 6;
    const float* modv = (const float*)(p.ws + OFF_MOD);
    const bf16_t* zp = (const bf16_t*)(p.ws + OFF_UCOMB);
    bf16_t* h = (bf16_t*)(p.ws + OFF_H1);
    const int stride = gridDim.x * 8;
    u32x2 nv[4];
    { const bf16_t* xr = zp + (size_t)(blockIdx.x * 8 + wid) * 1024;
#pragma unroll
      for (int i = 0; i < 4; ++i) nv[i] = *(const u32x2*)(xr + i * 256 + lane * 4); }
    for (int tok = blockIdx.x * 8 + wid; tok < NTOK; tok += stride) {
        f32x4 v[4]; float s = 0.f;
#pragma unroll
        for (int i = 0; i < 4; ++i) v[i] = unpk4(nv[i]);
        if (tok + stride < NTOK) {
            const bf16_t* xr = zp + (size_t)(tok + stride) * 1024;
#pragma unroll
            for (int i = 0; i < 4; ++i) nv[i] = *(const u32x2*)(xr + i * 256 + lane * 4);
        }
#pragma unroll
        for (int i = 0; i < 4; ++i) s += v[i][0] + v[i][1] + v[i][2] + v[i][3];
        float mu = wave_sum(s) * (1.f / 1024.f);
        float q = 0.f;
#pragma unroll
        for (int i = 0; i < 4; ++i) { v[i] = v[i] - mu; q += v[i][0] * v[i][0] + v[i][1] * v[i][1] + v[i][2] * v[i][2] + v[i][3] * v[i][3]; }
        float rstd = rsqrtf(wave_sum(q) * (1.f / 1024.f) + LN_EPS);
        s = 0.f;
#pragma unroll
        for (int i = 0; i < 4; ++i) { const int c = i * 256 + lane * 4; const f32x4 gg = *(const f32x4*)(p.ln_g + c), bb = *(const f32x4*)(p.ln_b + c);
            v[i] = v[i] * rstd * gg + bb; *(f32x4*)(p.out + OUT_Y + (size_t)tok * 1024 + c) = v[i]; s += v[i][0] + v[i][1] + v[i][2] + v[i][3]; }
        mu = wave_sum(s) * (1.f / 1024.f); q = 0.f;
#pragma unroll
        for (int i = 0; i < 4; ++i) { v[i] = v[i] - mu; q += v[i][0] * v[i][0] + v[i][1] * v[i][1] + v[i][2] * v[i][2] + v[i][3] * v[i][3]; }
        rstd = rsqrtf(wave_sum(q) * (1.f / 1024.f) + LN_EPS);
        const float* md = modv + (1 * 5 + cond_of(tok)) * 3072;
#pragma unroll
        for (int i = 0; i < 4; ++i) { const int c = i * 256 + lane * 4; const f32x4 sh = *(const f32x4*)(md + c), sc = *(const f32x4*)(md + 1024 + c);
            *(u32x2*)(h + (size_t)tok * 1024 + c) = pk4(v[i] * rstd * (sc + 1.f) + sh); }
    }
}
DI void phase_ln_final(const Params& p) {
    const int lane = threadIdx.x & 63, wid = threadIdx.x >> 6;
    const bf16_t* zp = (const bf16_t*)(p.ws + OFF_UO);
    const int stride = gridDim.x * 8;
    u32x2 nv[4];
    { const bf16_t* xr = zp + (size_t)(blockIdx.x * 8 + wid) * 1024;
#pragma unroll
      for (int i = 0; i < 4; ++i) nv[i] = *(const u32x2*)(xr + i * 256 + lane * 4); }
    for (int tok = blockIdx.x * 8 + wid; tok < NTOK; tok += stride) {
        f32x4 v[4]; float s = 0.f;
#pragma unroll
        for (int i = 0; i < 4; ++i) v[i] = unpk4(nv[i]);
        if (tok + stride < NTOK) {
            const bf16_t* xr = zp + (size_t)(tok + stride) * 1024;
#pragma unroll
            for (int i = 0; i < 4; ++i) nv[i] = *(const u32x2*)(xr + i * 256 + lane * 4);
        }
#pragma unroll
        for (int i = 0; i < 4; ++i) s += v[i][0] + v[i][1] + v[i][2] + v[i][3];
        const float mu = wave_sum(s) * (1.f / 1024.f);
        float q = 0.f;
#pragma unroll
        for (int i = 0; i < 4; ++i) { v[i] = v[i] - mu; q += v[i][0] * v[i][0] + v[i][1] * v[i][1] + v[i][2] * v[i][2] + v[i][3] * v[i][3]; }
        const float rstd = rsqrtf(wave_sum(q) * (1.f / 1024.f) + LN_EPS);
#pragma unroll
        for (int i = 0; i < 4; ++i) { const int c = i * 256 + lane * 4; const f32x4 gg = *(const f32x4*)(p.ln_g + 1024 + c), bb = *(const f32x4*)(p.ln_b + 1024 + c);
            *(f32x4*)(p.out + OUT_Y + (size_t)tok * 1024 + c) = v[i] * rstd * gg + bb; }
    }
}

template <int NI>
DI void carry_items(const Params& p, int g, const int (&seq)[NI], const int (&d)[NI], int pp) {
    const float* S = p.out + OUT_Y;
    bf16_t* ucomb = (bf16_t*)(p.ws + OFF_UCOMB);
    float ar[NI], ai[NI], Hr[NI], Hi[NI]; int chunk0[NI];
    const int nc = seq[0] < 32 ? 16 : 64;
#pragma unroll
    for (int q = 0; q < NI; ++q) {
        const float lr = p.lam_re[(d[q] * 64 + g) * 64 + pp], li = p.lam_im[(d[q] * 64 + g) * 64 + pp], dt = expf(p.log_dt[d[q] * 64 + g]);
        const float mag = expf(16.f * lr * dt); float sn, cs; sincosf(16.f * li * dt, &sn, &cs);
        ar[q] = mag * cs; ai[q] = mag * sn; Hr[q] = 0.f; Hi[q] = 0.f;
        if (seq[q] < 32) chunk0[q] = seq[q] * 16;
        else { const int sb = seq[q] - 32; chunk0[q] = 512 + sb * 64; const int si = ((sb * 2 + d[q]) * 64 + g) * 64 + pp; Hr[q] = p.st_re[si]; Hi[q] = p.st_im[si]; }
    }
    float sr[2][NI][8], si[2][NI][8];
#define CARRY_LOAD(SET, C8) do { _Pragma("unroll") for (int q = 0; q < NI; ++q) _Pragma("unroll") for (int j = 0; j < 8; ++j) { \
        const int chunk = chunk0[q] + (d[q] == 0 ? (C8) + j : nc - 1 - (C8) - j); const size_t row = (size_t)(g * 768 + chunk); \
        sr[SET][q][j] = S[row * 256 + d[q] * 128 + pp]; si[SET][q][j] = S[row * 256 + d[q] * 128 + 64 + pp]; } } while (0)
#define CARRY_STEP(SET, C8) do { _Pragma("unroll") for (int q = 0; q < NI; ++q) _Pragma("unroll") for (int j = 0; j < 8; ++j) { \
        const int chunk = chunk0[q] + (d[q] == 0 ? (C8) + j : nc - 1 - (C8) - j); const size_t row = (size_t)(g * 768 + chunk); \
        ucomb[row * 512 + 256 + d[q] * 128 + pp] = f2bf(Hr[q]); ucomb[row * 512 + 256 + d[q] * 128 + 64 + pp] = f2bf(Hi[q]); \
        const float nr = ar[q] * Hr[q] - ai[q] * Hi[q] + sr[SET][q][j], ni = ar[q] * Hi[q] + ai[q] * Hr[q] + si[SET][q][j]; Hr[q] = nr; Hi[q] = ni; } } while (0)
    CARRY_LOAD(0, 0);
    for (int c8 = 0; c8 < nc; c8 += 16) {
        CARRY_LOAD(1, c8 + 8);
        CARRY_STEP(0, c8);
        if (c8 + 16 < nc) CARRY_LOAD(0, c8 + 16);
        CARRY_STEP(1, c8 + 8);
    }
#undef CARRY_LOAD
#undef CARRY_STEP
#pragma unroll
    for (int q = 0; q < NI; ++q) if (seq[q] < 32) { const int oi = ((seq[q] * 2 + d[q]) * 64 + g) * 64 + pp; p.out[OUT_SR + oi] = Hr[q]; p.out[OUT_SI + oi] = Hi[q]; }
}
DI void carry_local(const Params& p, int g, int pm) {
    const int tid = threadIdx.x;
    if (pm < 2) {
#pragma unroll 1
        for (int h2 = 0; h2 < 2; ++h2) {
            int seq[2], d[2];
#pragma unroll
            for (int j = 0; j < 2; ++j) { const int item = tid + 512 * (2 * h2 + j); seq[j] = pm * 16 + (item >> 7); d[j] = (item >> 6) & 1; }
            carry_items<2>(p, g, seq, d, tid & 63);
        }
    } else { const int seq[1] = {32 + (tid >> 7)}, d[1] = {(tid >> 6) & 1}; carry_items<1>(p, g, seq, d, tid & 63); }
}

DI void phase_attn(const Params& p, char* smem_all) {
    const int team = threadIdx.x >> 8, tid = threadIdx.x & 255, lane = tid & 63, wid = tid >> 6, l31 = lane & 31, hh = lane >> 5;
    const int mp = wid >> 1, qsub = wid & 1;
    char* smem = smem_all + team * 36864;
    bf16_t* sK = (bf16_t*)smem;
    char* sV = smem + 16384;
    float* ex = (float*)smem;
    const bf16_t* Q = (const bf16_t*)(p.ws + OFF_Q);
    bf16_t* yab = (bf16_t*)(p.ws + OFF_YAB);
    const float lam = *(const float*)(p.ws + OFF_LAM);
    const int w = blockIdx.x;
    const int n_it = w < 128 ? 3 : (w < 192 ? 2 : 4);
    for (int it = 0; it < n_it; ++it) {
        const int pair = w < 192 ? (it == 0 ? w : (it == 1 ? 256 + w : 448 + w)) : (it == 0 ? w : 576 + (w - 192) * 3 + (it - 1));
        const int u = pair * 2 + team;
        int hd, Lk, tokq, ldv; const bf16_t *Kb, *Vb;
        if (u < 512) { const int b = u >> 7, r = u & 127; hd = r >> 4; const int qt = r & 15; Lk = 1280; ldv = 1280; tokq = NPTOK + b * 1024 + qt * 64;
            Kb = (const bf16_t*)(p.ws + OFF_KS) + (size_t)b * 1280 * 1024; Vb = (const bf16_t*)(p.ws + OFF_VTS) + (size_t)b * 1024 * 1280; }
        else { const int uu = u - 512, b = uu >> 5, r = uu & 31; hd = r >> 2; const int qt = r & 3; Lk = 256; ldv = 256; tokq = b * 256 + qt * 64;
            Kb = (const bf16_t*)(p.ws + OFF_KP) + (size_t)b * 256 * 1024; Vb = (const bf16_t*)(p.ws + OFF_VTP) + (size_t)b * 1024 * 256; }
        const int tok = tokq + qsub * 32 + l31;
        bf16x8 qf[4];
#pragma unroll
        for (int ks = 0; ks < 4; ++ks) qf[ks] = *(const bf16x8*)(Q + (size_t)tok * 1024 + hd * 128 + mp * 64 + ks * 16 + hh * 8);
        f32x16 o[4];
#pragma unroll
        for (int vb = 0; vb < 4; ++vb)
#pragma unroll
            for (int i = 0; i < 16; ++i) o[vb][i] = 0.f;
        float m_run = -1e30f, l_run = 0.f;
        const int nkt = Lk >> 6;
        u32x4 rk[4], rv[4];
#pragma unroll
        for (int i = 0; i < 4; ++i) { const int idx = tid + 256 * i, mm = idx >> 9, key = (idx >> 3) & 63, ch = idx & 7, vd = idx >> 3;
            rk[i] = *(const u32x4*)(Kb + (size_t)key * 1024 + hd * 128 + mm * 64 + ch * 8);
            rv[i] = *(const u32x4*)(Vb + (size_t)(hd * 128 + vd) * ldv + ch * 8); }
        for (int kt = 0; kt < nkt; ++kt) {
            __syncthreads();
#pragma unroll
            for (int i = 0; i < 4; ++i) { const int idx = tid + 256 * i, mm = idx >> 9, key = (idx >> 3) & 63, ch = idx & 7;
                *(u32x4*)(sK + (mm * 64 + key) * 64 + ((ch ^ (key & 7)) * 8)) = rk[i];
                const int vd = idx >> 3; char* d = sV + vd * 136 + ch * 16;
                *(u32x2*)d = (u32x2){rv[i].x, rv[i].y}; *(u32x2*)(d + 8) = (u32x2){rv[i].z, rv[i].w}; }
            __syncthreads();
            if (kt + 1 < nkt) {
#pragma unroll
                for (int i = 0; i < 4; ++i) { const int idx = tid + 256 * i, mm = idx >> 9, key = (idx >> 3) & 63, ch = idx & 7, vd = idx >> 3;
                    rk[i] = *(const u32x4*)(Kb + (size_t)((kt + 1) * 64 + key) * 1024 + hd * 128 + mm * 64 + ch * 8);
                    rv[i] = *(const u32x4*)(Vb + (size_t)(hd * 128 + vd) * ldv + (kt + 1) * 64 + ch * 8); }
            }
            f32x16 s[2];
#pragma unroll
            for (int kb = 0; kb < 2; ++kb) {
#pragma unroll
                for (int i = 0; i < 16; ++i) s[kb][i] = 0.f;
#pragma unroll
                for (int ks = 0; ks < 4; ++ks) {
                    const bf16x8 kf = *(const bf16x8*)(sK + (mp * 64 + kb * 32 + l31) * 64 + (((ks * 2 + hh) ^ (l31 & 7)) * 8));
                    s[kb] = __builtin_amdgcn_mfma_f32_32x32x16_bf16(kf, qf[ks], s[kb], 0, 0, 0);
                }
            }
            float mx = s[0][0];
#pragma unroll
            for (int i = 0; i < 16; ++i) { mx = fmaxf(mx, s[0][i]); mx = fmaxf(mx, s[1][i]); }
            mx = fmaxf(mx, __shfl_xor(mx, 32));
            const float mnew = fmaxf(m_run, mx);
            const float alpha = __builtin_amdgcn_exp2f((m_run - mnew) * LOG2E);
            const float mneg = -mnew * LOG2E;
            float rs = 0.f;
#pragma unroll
            for (int kb = 0; kb < 2; ++kb)
#pragma unroll
                for (int i = 0; i < 16; ++i) { const float e = __builtin_amdgcn_exp2f(__builtin_fmaf(s[kb][i], LOG2E, mneg)); s[kb][i] = e; rs += e; }
            rs += __shfl_xor(rs, 32);
            l_run = l_run * alpha + rs; m_run = mnew;
#pragma unroll
            for (int vb = 0; vb < 4; ++vb)
#pragma unroll
                for (int i = 0; i < 16; ++i) o[vb][i] *= alpha;
#pragma unroll
            for (int kb = 0; kb < 2; ++kb)
#pragma unroll
                for (int s2 = 0; s2 < 2; ++s2) {
                    u32x4 pw; pw.x = pk2(s[kb][8 * s2], s[kb][8 * s2 + 1]); pw.y = pk2(s[kb][8 * s2 + 2], s[kb][8 * s2 + 3]); pw.z = pk2(s[kb][8 * s2 + 4], s[kb][8 * s2 + 5]); pw.w = pk2(s[kb][8 * s2 + 6], s[kb][8 * s2 + 7]);
                    const bf16x8 pf = __builtin_bit_cast(bf16x8, pw);
#pragma unroll
                    for (int vb = 0; vb < 4; ++vb) {
                        const char* a = sV + (vb * 32 + l31) * 136 + (kb * 32 + 16 * s2 + 4 * hh) * 2;
                        const s16x4 v0 = *(const s16x4*)a, v1 = *(const s16x4*)(a + 16);
                        const bf16x8 vf = __builtin_shufflevector(v0, v1, 0, 1, 2, 3, 4, 5, 6, 7);
                        o[vb] = __builtin_amdgcn_mfma_f32_32x32x16_bf16(vf, pf, o[vb], 0, 0, 0);
                    }
                }
        }
        const float inv = 1.f / l_run;
        __syncthreads();
        if (mp == 1) {
#pragma unroll
            for (int vb = 0; vb < 4; ++vb)
#pragma unroll
                for (int i = 0; i < 16; ++i) ex[(qsub * 128 + vb * 32 + (i & 3) + 8 * (i >> 2) + 4 * hh) * 32 + l31] = o[vb][i] * inv;
        }
        __syncthreads();
        if (mp == 0) {
            float ss = 0.f;
#pragma unroll
            for (int vb = 0; vb < 4; ++vb)
#pragma unroll
                for (int i = 0; i < 16; ++i) { const float v = o[vb][i] * inv - lam * ex[(qsub * 128 + vb * 32 + (i & 3) + 8 * (i >> 2) + 4 * hh) * 32 + l31]; o[vb][i] = v; ss += v * v; }
            ss += __shfl_xor(ss, 32);
            const float rms = rsqrtf(ss * (1.f / 128.f) + LN_EPS) * (1.f - LAM_INIT);
#pragma unroll
            for (int vb = 0; vb < 4; ++vb)
#pragma unroll
                for (int q4 = 0; q4 < 4; ++q4) {
                    const int vd = vb * 32 + 8 * q4 + 4 * hh;
                    const f32x4 gg = *(const f32x4*)(p.subln_g + vd);
                    bf16_t* dst = yab + (size_t)tok * 2048 + 1024 + hd * 128 + vd;
                    const f32x4 sz = unpk4(*(const u32x2*)dst);
                    f32x4 r;
#pragma unroll
                    for (int e = 0; e < 4; ++e) r[e] = o[vb][4 * q4 + e] * rms * gg[e] * sz[e];
                    *(u32x2*)dst = pk4(r);
                }
        }
        __syncthreads();
    }
}
#define XB_TMO      128
#define XB_XCNT(j)  (256  + 64 * (j))
#define XB_XSUB(j)  (1280 + 64 * (j))
#define XB_XGEN(j)  (2304 + 64 * (j))
#define XB_TOP      3328
#define XB_TOPGEN   3392
#define XCD_BAR_WORDS 3456
#define XB_SPIN_CAP (1u << 20)
DI unsigned xb_ld(unsigned* p)              { return __hip_atomic_load(p, __ATOMIC_RELAXED, __HIP_MEMORY_SCOPE_AGENT); }
DI unsigned xb_add(unsigned* p, unsigned v) { return __hip_atomic_fetch_add(p, v, __ATOMIC_RELAXED, __HIP_MEMORY_SCOPE_AGENT); }
DI unsigned xb_xcc_id() { return (unsigned)__builtin_amdgcn_s_getreg((3 << 11) | 20) & 0xFu; }
#define XB_SPIN(cond, bar) do { unsigned _sp = 0; while (cond) { __builtin_amdgcn_s_sleep(1); \
    if ((++_sp & 255u) == 0u) { if (xb_ld(&(bar)[XB_TMO])) break; if (_sp > XB_SPIN_CAP) { atomicAdd(&(bar)[XB_TMO], 1u); break; } } } } while (0)
struct XcdBarrier { unsigned* bar; unsigned x; volatile unsigned* st; };
DI XcdBarrier xb_init(unsigned* bar, volatile unsigned* st) {
    XcdBarrier b; b.bar = bar; b.x = xb_xcc_id(); b.st = st;
    if (threadIdx.x == 0) {
        (void)xb_add(&bar[XB_XCNT(b.x)], 1u);
        const unsigned G = gridDim.x;
        unsigned sum, cnt, mine, sp = 0u;
        for (;;) {
            sum = 0u; cnt = 0u; mine = 0u;
#pragma unroll
            for (unsigned j = 0; j < 16; ++j) { const unsigned c = xb_ld(&bar[XB_XCNT(j)]); sum += c; cnt += (c > 0u) ? 1u : 0u; mine = (j == b.x) ? c : mine; }
            if (sum == G) break;
            __builtin_amdgcn_s_sleep(1);
            if ((++sp & 255u) == 0u) { if (xb_ld(&bar[XB_TMO])) break; if (sp > XB_SPIN_CAP) { atomicAdd(&bar[XB_TMO], 1u); break; } }
        }
        st[0] = mine > 0u ? mine : 1u; st[1] = cnt > 0u ? cnt : 1u;
    }
    return b;
}
DI void xcd_barrier(const XcdBarrier& b) {
    asm volatile("s_waitcnt vmcnt(0)" ::: "memory");
    __syncthreads();
    if (threadIdx.x == 0) {
        unsigned* bar = b.bar;
        __builtin_amdgcn_s_waitcnt(0);
        const unsigned nloc = b.st[0], nx = b.st[1];
        const unsigned old = xb_add(&bar[XB_XSUB(b.x)], 1u);
        const unsigned gen = old / nloc;
        if (old + 1u == (gen + 1u) * nloc) {
            __builtin_amdgcn_fence(__ATOMIC_RELEASE, "agent");
            asm volatile("s_waitcnt vmcnt(0)" ::: "memory");
            const unsigned og = xb_add(&bar[XB_TOP], 1u);
            const unsigned tg = og / nx;
            if (og + 1u == (tg + 1u) * nx) xb_add(&bar[XB_TOPGEN], 1u);
            else XB_SPIN(xb_ld(&bar[XB_TOPGEN]) == tg, bar);
            __builtin_amdgcn_fence(__ATOMIC_ACQUIRE, "agent");
            xb_add(&bar[XB_XGEN(b.x)], 1u);
            asm volatile("s_waitcnt vmcnt(0)" ::: "memory");
        } else {
            XB_SPIN(xb_ld(&bar[XB_XGEN(b.x)]) == gen, bar);
            __builtin_amdgcn_fence(__ATOMIC_ACQUIRE, "agent");
            asm volatile("s_waitcnt vmcnt(0)" ::: "memory");
        }
    }
    __syncthreads();
}

DI void warm_code(unsigned long long base) {
    if (threadIdx.x < 416) {
        const char* a = (const char*)base + ((blockIdx.x >> 3) & 31) * 6656 + threadIdx.x * 16;
        u32x4 t;
        asm volatile("global_load_dwordx4 %0, %1, off\n\ts_waitcnt vmcnt(0)" : "=v"(t) : "v"(a) : "memory");
    }
}

#ifndef ONLY
#define ONLY -1
#endif
#define PHASE(i, ...) if ((ONLY < 0 || ONLY == (i)) && ph_lo <= (i) && (i) < ph_hi) { if ((i) > ph_lo) { warm_code(code_base); xcd_barrier(xb); } __VA_ARGS__ }

constexpr int LDS_BYTES = 147456;
__global__ void __launch_bounds__(512, 2) mega(Params p, int ph_lo, int ph_hi) {
    extern __shared__ __attribute__((aligned(16))) unsigned char lds_raw[];
    PG8_LAS unsigned char* lds = (PG8_LAS unsigned char*)lds_raw;
    char* smem = (char*)lds_raw;
    cg::grid_group grid = cg::this_grid();
    char* ws = p.ws;
    if (ph_lo < 0) grid.sync();
    unsigned long long code_base = __builtin_amdgcn_s_getpc() & ~0xFFFull;
    asm volatile("" : "+s"(code_base));
    warm_code(code_base);
    const XcdBarrier xb = xb_init((unsigned*)(ws + OFF_BAR), (volatile unsigned*)(lds_raw + LDS_BYTES - 16));
    const float* modv = (const float*)(ws + OFF_MOD);
    PHASE(0, { if (blockIdx.x < 64) convert_wt_sub(p.w_glu, (bf16_t*)(ws + OFF_WGLU), 1024, 1024, smem, (int)blockIdx.x, 64);
               phase_prep(p, smem); })
    PHASE(1, { phase_ln0(p); })
    PHASE(2, {
        GemmDesc g{(const bf16_t*)(ws + OFF_H0), (const bf16_t*)(ws + OFF_WINE), 0, 0, 1024, 1024, NTOK, 6144, 1024, 1};
        EpiInE e{(bf16_t*)(ws + OFF_UCOMB), (bf16_t*)(ws + OFF_YAB), (bf16_t*)(ws + OFF_Q), (bf16_t*)(ws + OFF_KP), (bf16_t*)(ws + OFF_KS), (bf16_t*)(ws + OFF_VTP), (bf16_t*)(ws + OFF_VTS), p.out,
                 (const float*)(ws + OFF_ROPEC), (const float*)(ws + OFF_ROPES)};
        gemm_run(g, e, lds);
        if (blockIdx.x >= 128) phase_prep_late(p, smem, (int)blockIdx.x - 128, 128); })
    PHASE(3, {
        { GemmDesc g{(const bf16_t*)(ws + OFF_UCOMB), (const bf16_t*)(ws + OFF_WS), 768L * 512, 256L * 256, 512, 256, 768, 256, 256, 64};
          EpiS e{p.out + OUT_Y};
          gemm_run(g, e, lds); }
        __threadfence_block(); __syncthreads();
        if (blockIdx.x < 192) carry_local(p, (int)blockIdx.x / 3, (int)blockIdx.x % 3);
        __threadfence_block(); __syncthreads();
        { GemmDesc g{(const bf16_t*)(ws + OFF_UCOMB), (const bf16_t*)(ws + OFF_WY), 768L * 512, 256L * 512, 512, 512, 768, 256, 512, 64};
          EpiY e{(bf16_t*)(ws + OFF_H0)};
          gemm_run(g, e, lds); }
        phase_attn(p, smem); })
    PHASE(4, {
        GemmDesc g{(const bf16_t*)(ws + OFF_H0), (const bf16_t*)(ws + OFF_WGLU), 0, 0, 1024, 1024, NTOK, 1024, 1024, 1};
        EpiGlu e{(const bf16_t*)(ws + OFF_H0), (bf16_t*)(ws + OFF_YAB), p.b_glu};
        gemm_run(g, e, lds);
        if (blockIdx.x >= 192) { phase_prep_later(p, smem, (int)blockIdx.x - 192, 64);
            convert_wt_sub(p.w_out_o, (bf16_t*)(ws + OFF_WOUTO), 2048, 1024, smem, (int)blockIdx.x - 192, 64); } })
    PHASE(5, {
        GemmDesc g{(const bf16_t*)(ws + OFF_YAB), (const bf16_t*)(ws + OFF_WOUTE), 0, 0, 2048, 2048, NTOK, 1024, 2048, 1};
        EpiRes e{p.x_prompt, p.x_sample, NPTOK, modv, (bf16_t*)(ws + OFF_UCOMB)};
        gemm_run(g, e, lds);
        if (blockIdx.x >= 192) {
            convert_wt_sub(p.w_in_o, (bf16_t*)(ws + OFF_WINO), 1024, 4096, smem, (int)blockIdx.x - 192, 64);
            convert_wt_sub(p.w_fno, (bf16_t*)(ws + OFF_WFNO), 2048, 2048, smem, (int)blockIdx.x - 192, 64);
 } })
    PHASE(6, { phase_ln_mid(p); })
    PHASE(7, {
        GemmDesc g{(const bf16_t*)(ws + OFF_H1), (const bf16_t*)(ws + OFF_WINO), 0, 0, 1024, 1024, NTOK, 4096, 1024, 1};
        EpiInO e{(bf16_t*)(ws + OFF_UO), (bf16_t*)(ws + OFF_ZO)};
        gemm_run(g, e, lds); })
    PHASE(8, {
        GemmDesc g{(const bf16_t*)(ws + OFF_WDFT), (const bf16_t*)(ws + OFF_UO), 0, 256, 256, 2048, 512, NTOK, 256, 8};
        EpiDftA e{(bf16_t*)(ws + OFF_TP), (bf16_t*)(ws + OFF_TS)};
        gemm_run(g, e, lds); })
    PHASE(9, {
        { GemmDesc g{(const bf16_t*)(ws + OFF_DL1K), (const bf16_t*)(ws + OFF_TS), 0, 2048L * 2048, 2048, 2048, 1024, 2048, 2048, 4};
          EpiDftB e{(bf16_t*)(ws + OFF_UO), NPTOK, 1024};
          gemm_run(g, e, lds); }
        { GemmDesc g{(const bf16_t*)(ws + OFF_DL256), (const bf16_t*)(ws + OFF_TP), 0, 2048L * 512, 512, 512, 256, 2048, 512, 32};
          EpiDftB e{(bf16_t*)(ws + OFF_UO), 0, 256};
          gemm_run(g, e, lds, 128, 128); } })
    PHASE(10, {
        GemmDesc g{(const bf16_t*)(ws + OFF_UO), (const bf16_t*)(ws + OFF_WFNO), 0, 0, 2048, 2048, NTOK, 2048, 2048, 1};
        EpiFno e{(const bf16_t*)(ws + OFF_ZO), (bf16_t*)(ws + OFF_Y1), p.b_fno};
        gemm_run(g, e, lds); })
    PHASE(11, {
        GemmDesc g{(const bf16_t*)(ws + OFF_Y1), (const bf16_t*)(ws + OFF_WOUTO), 0, 0, 2048, 2048, NTOK, 1024, 2048, 1};
        EpiRes e{p.out + OUT_Y, p.out + OUT_Y, NTOK, modv + 5 * 3072, (bf16_t*)(ws + OFF_UO)};
        gemm_run(g, e, lds); })
    PHASE(12, { phase_ln_final(p); })
}

extern "C" void kernel_launch(void* const* d_in, const int* in_sizes, int n_in, void* d_out, int out_size, void* d_ws, size_t ws_size, hipStream_t stream) {
    (void)in_sizes; (void)n_in; (void)out_size; (void)ws_size;
    Params p{};
    const float** f = (const float**)&p;
    for (int i = 0; i < 33; ++i) f[i] = (const float*)d_in[i];
    p.out = (float*)d_out; p.ws = (char*)d_ws;
    static int grid_blocks = 0;
    if (!grid_blocks) {
        int dev = 0, cus = 0, per_cu = 0;
        (void)hipGetDevice(&dev);
        (void)hipDeviceGetAttribute(&cus, hipDeviceAttributeMultiprocessorCount, dev);
        (void)hipFuncSetAttribute((const void*)mega, hipFuncAttributeMaxDynamicSharedMemorySize, LDS_BYTES);
        (void)hipOccupancyMaxActiveBlocksPerMultiprocessor(&per_cu, mega, 512, LDS_BYTES);
        if (per_cu > 1) per_cu = 1;
        if (per_cu < 1) per_cu = 1;
        grid_blocks = cus * per_cu;
    }
    (void)hipMemsetAsync((char*)d_ws + OFF_BAR, 0, XCD_BAR_WORDS * sizeof(unsigned), stream);
    int lo = 0, hi = 13;
    void* args[] = {&p, &lo, &hi};
    hipError_t e = hipLaunchCooperativeKernel((void*)mega, dim3(grid_blocks), dim3(512), args, LDS_BYTES, stream);
    if (e != hipSuccess) fprintf(stderr, "cooperative launch failed: %s (grid %d)\n", hipGetErrorString(e), grid_blocks);
}
```

```cpp
#include <hip/hip_runtime.h>
#include <hip/hip_cooperative_groups.h>
#include <cstdio>
#include <cstdint>
namespace cg = cooperative_groups;

typedef unsigned short bf16_t;
typedef short bf16x8 __attribute__((ext_vector_type(8)));
typedef short s16x4 __attribute__((ext_vector_type(4)));
typedef float f32x4 __attribute__((ext_vector_type(4)));
typedef float f32x2 __attribute__((ext_vector_type(2)));
typedef float f32x16 __attribute__((ext_vector_type(16)));
typedef unsigned u32x4 __attribute__((ext_vector_type(4)));
typedef unsigned u32x2 __attribute__((ext_vector_type(2)));
typedef __bf16 bfv2 __attribute__((ext_vector_type(2)));

#define DI __device__ __forceinline__

constexpr int NTOK = 12288, NPTOK = 8192, DM = 1024;
constexpr float LN_EPS = 1e-5f;
constexpr float ALPHA = 1.41421356237f;
constexpr float LAM_INIT = 0.2f;
constexpr float LOG2E = 1.4426950408889634f;

constexpr size_t MiB = 1024ull * 1024ull;
constexpr size_t OFF_MOD   = 0;
constexpr size_t OFF_ROPEC = 256 * 1024;
constexpr size_t OFF_ROPES = 384 * 1024;
constexpr size_t OFF_LAM   = 512 * 1024;
constexpr size_t OFF_BAR   = 1024 * 1024;
constexpr size_t OFF_WDFT  = 2 * MiB;
constexpr size_t OFF_DL256 = 2 * MiB + 256 * 1024;
constexpr size_t OFF_DL1K  = 3 * MiB;
constexpr size_t OFF_WINE  = 8 * MiB;
constexpr size_t OFF_WGLU  = 20 * MiB;
constexpr size_t OFF_WOUTE = 22 * MiB;
constexpr size_t OFF_WS    = 26 * MiB;
constexpr size_t OFF_WY    = 34 * MiB;
constexpr size_t OFF_H0    = 50 * MiB;
constexpr size_t OFF_UCOMB = 74 * MiB;
constexpr size_t OFF_YAB   = 122 * MiB;
constexpr size_t OFF_Q     = 170 * MiB;
constexpr size_t OFF_KP    = 194 * MiB;
constexpr size_t OFF_KS    = 210 * MiB;
constexpr size_t OFF_VTP   = 220 * MiB;
constexpr size_t OFF_VTS   = 236 * MiB;
constexpr size_t OFF_WINO  = 8 * MiB;
constexpr size_t OFF_WFNO  = 26 * MiB;
constexpr size_t OFF_WOUTO = 16 * MiB;
constexpr size_t OFF_H1    = 34 * MiB;
constexpr size_t OFF_UO    = 58 * MiB;
constexpr size_t OFF_ZO    = 106 * MiB;
constexpr size_t OFF_TP    = 154 * MiB;
constexpr size_t OFF_TS    = 218 * MiB;
constexpr size_t OFF_Y1    = 154 * MiB;
constexpr size_t OUT_Y  = 0;
constexpr size_t OUT_CK = 12582912;
constexpr size_t OUT_CV = 20971520;
constexpr size_t OUT_SR = 29360128;
constexpr size_t OUT_SI = 29622272;

struct Params {
    const float *x_prompt, *x_sample, *cache_k, *cache_v, *st_re, *st_im, *c, *c_ctx, *w_mod, *b_mod, *ln_g, *ln_b, *w_in_e,
        *lam_re, *lam_im, *log_dt, *b_re, *b_im, *c_re, *c_im, *ssm_d, *w_glu, *b_glu, *lq1, *lk1, *lq2, *lk2, *subln_g, *w_out_e,
        *w_in_o, *w_fno, *b_fno, *w_out_o;
    float* out;
    char* ws;
};

DI float bf2f(bf16_t b) { return __uint_as_float(((unsigned)b) << 16); }
DI unsigned pk2(float lo, float hi) { f32x2 v = {lo, hi}; bfv2 b = __builtin_convertvector(v, bfv2); return __builtin_bit_cast(unsigned, b); }
DI bf16_t f2bf(float x) { return (bf16_t)(pk2(x, 0.f) & 0xffffu); }
DI u32x2 pk4(f32x4 v) { u32x2 r; r.x = pk2(v[0], v[1]); r.y = pk2(v[2], v[3]); return r; }
DI f32x4 unpk4(u32x2 r) { f32x4 v; v[0] = __uint_as_float(r.x << 16); v[1] = __uint_as_float(r.x & 0xffff0000u); v[2] = __uint_as_float(r.y << 16); v[3] = __uint_as_float(r.y & 0xffff0000u); return v; }
DI float siluf(float x) { return x / (1.f + __expf(-x)); }
DI float gelu_tanh(float x) { float u = 0.7978845608028654f * (x + 0.044715f * x * x * x); float e = __expf(2.f * u); return 0.5f * x * (2.f - 2.f / (1.f + e)); }
DI float wave_sum(float v) {
#pragma unroll
    for (int o = 32; o; o >>= 1) v += __shfl_xor(v, o);
    return v;
}
DI int cond_of(int tok) { return tok < NPTOK ? 0 : 1 + ((tok - NPTOK) >> 10); }
DI const float* xin(const Params& p, int tok) { return tok < NPTOK ? p.x_prompt + (size_t)tok * DM : p.x_sample + (size_t)(tok - NPTOK) * DM; }

#define PG8_LAS __attribute__((address_space(3)))
namespace pg8 {
constexpr int BM = 256, BK = 64, HALF = 128, HTB = HALF * BK * 2, STAGE_BYTES = 8 * HTB, NXCD = 8, WGM = 2;
DI int lds_byte(int r, int c) { const int st = (r >> 4) * 2 + (c >> 5), rr = r & 15, cc = c & 31, ob = rr * 64 + cc * 2; return st * 1024 + (ob ^ (((ob >> 9) & 1) << 5)); }
DI void stage_rc(int b, int& R, int& C) { const int st = b / 1024, sb = b % 1024, swz = sb ^ (((sb >> 9) & 1) << 5); R = (st >> 1) * 16 + swz / 64; C = (st & 1) * 32 + (swz % 64) / 2; }
DI int perm32(int rho) { const int n = rho >> 4, i = rho & 15; return 8 * (i >> 2) + 4 * n + (i & 3); }
struct Unit { int pm, pn, z; };
struct Gemm { const bf16_t* A; const bf16_t* Bt; long az, bz; int lda, ldb, M, N, K, Z; };
struct Order {
    int nM, nN, nwg, total, G, c, Z;
    DI void init(int M, int N, int Z_, int G_, int c_) { nM = M / BM; nN = N / BM; nwg = nM * nN; Z = Z_; total = nwg * Z_; G = G_; c = c_; }
    DI bool next(int i, Unit& u) const {
        const int L = i * G + c; if (L >= total) return false;
        if (Z == 1) {
            int wgid = L; { const int q = nwg / NXCD, r = nwg % NXCD, xcd = wgid % NXCD, off = wgid / NXCD; wgid = (xcd < r ? xcd * (q + 1) : r * (q + 1) + (xcd - r) * q) + off; }
            const int nig = WGM * nN, gid = wgid / nig, fm = gid * WGM, gsz = (nM - fm) < WGM ? (nM - fm) : WGM;
            u.pm = fm + ((wgid % nig) % gsz); u.pn = (wgid % nig) / gsz; u.z = 0;
        } else { const int z = (int)((unsigned)L / (unsigned)nwg), r = L - z * nwg; u.z = z; u.pm = r % nM; u.pn = r / nM; }
        return true;
    }
    DI void a_ready(const Unit&) const {}
    DI void done(const Unit&) const {}
};
template <class F> struct Epi {
    static constexpr bool PERM = true, AFTER_DRAIN = false;
    F f;
    DI void operator()(const f32x4 (&acc)[2][2][4][2], const Unit& u, int wr, int wc, int fr, int fq) const {
#pragma unroll
        for (int ai = 0; ai < 2; ++ai)
#pragma unroll
            for (int m = 0; m < 4; ++m) {
                const int row = u.pm * BM + ai * HALF + wr * 64 + m * 16 + fr;
#pragma unroll
                for (int bj = 0; bj < 2; ++bj) f(u.z, row, u.pn * BM + bj * HALF + wc * 32 + 8 * fq, acc[ai][bj][m][0], acc[ai][bj][m][1]);
                asm volatile("" ::: "memory");
            }
    }
};
template <class EpiT, class Sched, bool ALIGN_EPI = true>
DI void gemm_phase(PG8_LAS unsigned char* lds, const Gemm g, const Sched& S, const EpiT& E) {
    const int tid = threadIdx.x, wid = __builtin_amdgcn_readfirstlane(tid >> 6), lane = tid & 63, wr = wid >> 2, wc = wid & 3, fr = lane & 15, fq = lane >> 4;
    const int K = g.K, nt = K / BK;
    unsigned voffA, voffB;
    { int R, C; stage_rc(tid * 16, R, C); const int Rb = EpiT::PERM ? ((R & ~31) + perm32(R & 31)) : R; voffA = (unsigned)(R * g.lda + C) * 2u; voffB = (unsigned)(Rb * g.ldb + C) * 2u; }
    const size_t r64voffA = (size_t)64 * g.lda * 2, r64voffB = (size_t)64 * g.ldb * 2;
    const size_t kstep = (size_t)(BK * 2);
    const size_t hstepA = (size_t)HALF * g.lda * 2, hstepB = (size_t)HALF * g.ldb * 2;
    const size_t tstepA = 2 * hstepA, tstepB = 2 * hstepB;
    const unsigned ldsw = (unsigned)wid * 1024u;
    const int aoff = lds_byte(wr * 64 + fr, fq * 8), boff = lds_byte(wc * 32 + fr, fq * 8);
#define PG8_SA(b, h) (((b) * 2 + (h)) * HTB)
#define PG8_SB(b, h) ((4 + (b) * 2 + (h)) * HTB)
#define PG8_STAGE(bufoff, gbase, voff) do { \
        __builtin_amdgcn_global_load_lds((const unsigned*)((const char*)(gbase) + (voff)), (PG8_LAS unsigned*)(lds + (bufoff) + ldsw), 16, 0, 0); \
        __builtin_amdgcn_global_load_lds((const unsigned*)((const char*)(gbase) + r64##voff + (voff)), (PG8_LAS unsigned*)(lds + (bufoff) + ldsw + 8192), 16, 0, 0); } while (0)
#define PG8_LDA(dst, b, h) do { _Pragma("unroll") for (int m = 0; m < 4; ++m) _Pragma("unroll") for (int k = 0; k < 2; ++k) dst[m][k] = *(const PG8_LAS bf16x8*)(lds + PG8_SA(b, h) + aoff + m * 2048 + k * 1024); } while (0)
#define PG8_LDB(dst, b, h) do { _Pragma("unroll") for (int n = 0; n < 2; ++n) _Pragma("unroll") for (int k = 0; k < 2; ++k) dst[n][k] = *(const PG8_LAS bf16x8*)(lds + PG8_SB(b, h) + boff + n * 2048 + k * 1024); } while (0)
#define PG8_MMA(ai, bj, At, Bt) do { __builtin_amdgcn_s_setprio(1); _Pragma("unroll") for (int m = 0; m < 4; ++m) _Pragma("unroll") for (int n = 0; n < 2; ++n) _Pragma("unroll") for (int k = 0; k < 2; ++k) \
        acc[ai][bj][m][n] = __builtin_amdgcn_mfma_f32_16x16x32_bf16(Bt[n][k], At[m][k], acc[ai][bj][m][n], 0, 0, 0); __builtin_amdgcn_s_setprio(0); } while (0)
#define PG8_WAIT_V(n) asm volatile("s_waitcnt vmcnt(" #n ")" ::: "memory")
#define PG8_WAIT_L(n) asm volatile("s_waitcnt lgkmcnt(" #n ")" ::: "memory")
#define PG8_BAR __builtin_amdgcn_s_barrier()
#define PG8_SCHED __builtin_amdgcn_sched_barrier(0)
    Unit cur, nxt; int ui = 0;
    if (!S.next(0, cur)) return;
    f32x4 acc[2][2][4][2];
#pragma unroll
    for (int a = 0; a < 2; ++a)
#pragma unroll
        for (int b = 0; b < 2; ++b)
#pragma unroll
            for (int m = 0; m < 4; ++m)
#pragma unroll
                for (int n = 0; n < 2; ++n) acc[a][b][m][n] = (f32x4){0.f, 0.f, 0.f, 0.f};
    bf16x8 At[4][2], B0[2][2], B1[2][2];
    const char* cA = (const char*)g.A + (size_t)cur.z * g.az * 2 + (size_t)cur.pm * tstepA; const char* cB = (const char*)g.Bt + (size_t)cur.z * g.bz * 2 + (size_t)cur.pn * tstepB;
    S.a_ready(cur);
    PG8_STAGE(PG8_SB(0, 0), cB, voffB); PG8_STAGE(PG8_SB(0, 1), cB + hstepB, voffB); PG8_STAGE(PG8_SA(0, 0), cA, voffA); PG8_STAGE(PG8_SA(0, 1), cA + hstepA, voffA);
    if (wr == 1) PG8_BAR;
    PG8_WAIT_V(2); PG8_BAR;
    PG8_STAGE(PG8_SB(1, 0), cB + kstep, voffB); PG8_STAGE(PG8_SA(1, 0), cA + kstep, voffA); PG8_STAGE(PG8_SB(1, 1), cB + hstepB + kstep, voffB);
    PG8_WAIT_V(6); PG8_BAR;
    for (;;) {
        const bool has_next = S.next(ui + 1, nxt);
        const char* nA = has_next ? (const char*)g.A + (size_t)nxt.z * g.az * 2 + (size_t)nxt.pm * tstepA : cA; const char* nB = has_next ? (const char*)g.Bt + (size_t)nxt.z * g.bz * 2 + (size_t)nxt.pn * tstepB : cB;
#pragma unroll 1
        for (int t = 0; t < nt; t += 2) {
            const bool last = (t == nt - 2);
            const char* a1 = cA + (size_t)(t + 1) * kstep;
            const char* a2 = last ? nA : cA + (size_t)(t + 2) * kstep; const char* b2 = last ? nB : cB + (size_t)(t + 2) * kstep;
            const char* a3 = a2 + kstep; const char* b3 = b2 + kstep;
            if (last && has_next) S.a_ready(nxt);
            PG8_LDB(B0, 0, 0); PG8_LDB(B1, 0, 1); PG8_SCHED; PG8_LDA(At, 0, 0); PG8_STAGE(PG8_SA(1, 1), a1 + hstepA, voffA);
            PG8_WAIT_V(8); PG8_WAIT_L(0); PG8_BAR; PG8_MMA(0, 0, At, B0); PG8_MMA(0, 1, At, B1); PG8_BAR; PG8_SCHED;
            PG8_LDA(At, 0, 1); PG8_STAGE(PG8_SB(0, 0), b2, voffB); PG8_STAGE(PG8_SB(0, 1), b2 + hstepB, voffB); PG8_STAGE(PG8_SA(0, 0), a2, voffA);
            PG8_WAIT_V(8); PG8_WAIT_L(0); PG8_BAR; PG8_MMA(1, 0, At, B0); PG8_MMA(1, 1, At, B1); PG8_BAR; PG8_SCHED;
            PG8_LDB(B0, 1, 0); PG8_LDB(B1, 1, 1); PG8_SCHED; PG8_LDA(At, 1, 0); PG8_STAGE(PG8_SA(0, 1), a2 + hstepA, voffA);
            PG8_WAIT_V(8); PG8_WAIT_L(0); PG8_BAR; PG8_MMA(0, 0, At, B0); PG8_MMA(0, 1, At, B1); PG8_BAR; PG8_SCHED;
            PG8_LDA(At, 1, 1); PG8_STAGE(PG8_SB(1, 0), b3, voffB); PG8_STAGE(PG8_SB(1, 1), b3 + hstepB, voffB); PG8_STAGE(PG8_SA(1, 0), a3, voffA);
            PG8_WAIT_V(8); PG8_WAIT_L(0); PG8_BAR; PG8_MMA(1, 0, At, B0); PG8_MMA(1, 1, At, B1); PG8_BAR; PG8_SCHED;
        }
        if constexpr (ALIGN_EPI) { if (wr == 0) PG8_BAR; }
        E(acc, cur, wr, wc, fr, fq); S.done(cur);
        if (!has_next) break;
#pragma unroll
        for (int a = 0; a < 2; ++a)
#pragma unroll
            for (int b = 0; b < 2; ++b)
#pragma unroll
                for (int m = 0; m < 4; ++m)
#pragma unroll
                    for (int n = 0; n < 2; ++n) acc[a][b][m][n] = (f32x4){0.f, 0.f, 0.f, 0.f};
        cur = nxt; cA = nA; cB = nB; ++ui;
        if constexpr (ALIGN_EPI) { if (wr == 1) PG8_BAR; }
    }
    PG8_WAIT_V(0);
    if constexpr (!ALIGN_EPI) { if (wr == 0) PG8_BAR; }
    PG8_BAR;
#undef PG8_SA
#undef PG8_SB
#undef PG8_STAGE
#undef PG8_LDA
#undef PG8_LDB
#undef PG8_MMA
#undef PG8_WAIT_V
#undef PG8_WAIT_L
#undef PG8_BAR
#undef PG8_SCHED
}
}
typedef pg8::Gemm GemmDesc;
template <class F>
DI void gemm_run(const GemmDesc g, const F f, PG8_LAS unsigned char* lds, int wg0 = 0, int nwg = 0) {
    if (nwg == 0) nwg = (int)gridDim.x;
    const int c = (int)blockIdx.x - wg0;
    pg8::Order S; S.init(g.M, g.N, g.Z, nwg, c);
    if (c < 0 || c >= nwg) { S.total = 0; S.c = 0; }
    const pg8::Epi<F> E{f};
    pg8::gemm_phase<pg8::Epi<F>, pg8::Order, true>(lds, g, S, E);
    __syncthreads();
}

DI u32x4 pk8(f32x4 a, f32x4 b) { u32x4 r; r.x = pk2(a[0], a[1]); r.y = pk2(a[2], a[3]); r.z = pk2(b[0], b[1]); r.w = pk2(b[2], b[3]); return r; }
DI void unpk8(u32x4 r, f32x4& a, f32x4& b) { a = unpk4((u32x2){r.x, r.y}); b = unpk4((u32x2){r.z, r.w}); }
DI int qk_perm(int c) { const int c6 = c & 63; return (c & ~63) + 32 * ((c6 >> 2) & 1) + 4 * (c6 >> 3) + (c6 & 3); }
struct EpiInE {
    bf16_t *ucomb, *yab, *q, *kP, *kS, *vTP, *vTS; float* out; const float *rc, *rs;
    DI void operator()(int, int m, int n, f32x4 lo, f32x4 hi) const {
        const int seg = n >> 10, nn = n & 1023;
        const bool samp = m >= NPTOK;
        if (seg == 0) {
            const int chunk = m >> 4, t = m & 15, g = nn >> 4, mm = nn & 15;
            *(u32x4*)(ucomb + ((size_t)(g * 768 + chunk) * 512 + t * 16 + mm)) = pk8(lo, hi);
        } else if (seg == 1 || seg == 5) {
            f32x4 a, b;
#pragma unroll
            for (int e = 0; e < 4; ++e) { a[e] = siluf(lo[e]); b[e] = siluf(hi[e]); }
            *(u32x4*)(yab + (size_t)m * 2048 + (seg == 5 ? 1024 : 0) + nn) = pk8(a, b);
        } else if (seg == 2 || seg == 3) {
            const int j0 = (nn & 63) >> 1, ft = (nn & ~63) + j0;
            if (!samp && seg == 3) { float* o = out + OUT_CK + (size_t)m * 1024 + ft; *(f32x4*)o = lo; *(f32x4*)(o + 32) = hi; }
            if (samp) {
                const int pos = (m - NPTOK) & 1023;
                const f32x4 cs = *(const f32x4*)(rc + pos * 32 + j0), sn = *(const f32x4*)(rs + pos * 32 + j0);
                const f32x4 a = lo * cs - hi * sn, b = lo * sn + hi * cs; lo = a; hi = b;
            }
            if (seg == 2) { lo = lo * 0.125f; hi = hi * 0.125f; bf16_t* dst = q + (size_t)m * 1024 + ft; *(u32x2*)dst = pk4(lo); *(u32x2*)(dst + 32) = pk4(hi); }
            else {
                bf16_t* dst;
                if (!samp) dst = kP + (size_t)m * 1024 + ft;
                else { const int b = (m - NPTOK) >> 10, pos = (m - NPTOK) & 1023; dst = kS + ((size_t)(b * 1280 + 256 + pos)) * 1024 + ft; }
                *(u32x2*)dst = pk4(lo); *(u32x2*)(dst + 32) = pk4(hi);
            }
        } else {
            if (!samp) {
                float* o = out + OUT_CV + (size_t)m * 1024 + nn; *(f32x4*)o = lo; *(f32x4*)(o + 4) = hi;
                const int b = m >> 8, pos = m & 255;
                bf16_t* dst = vTP + ((size_t)(b * 1024 + nn)) * 256 + pos;
#pragma unroll
                for (int e = 0; e < 4; ++e) { dst[(size_t)e * 256] = f2bf(lo[e]); dst[(size_t)(e + 4) * 256] = f2bf(hi[e]); }
            } else {
                const int b = (m - NPTOK) >> 10, pos = (m - NPTOK) & 1023;
                bf16_t* dst = vTS + ((size_t)(b * 1024 + nn)) * 1280 + 256 + pos;
#pragma unroll
                for (int e = 0; e < 4; ++e) { dst[(size_t)e * 1280] = f2bf(lo[e]); dst[(size_t)(e + 4) * 1280] = f2bf(hi[e]); }
            }
        }
    }
};
struct EpiS {
    float* S;
    DI void operator()(int z, int m, int n, f32x4 lo, f32x4 hi) const { float* o = S + ((size_t)(z * 768 + m)) * 256 + n; *(f32x4*)o = lo; *(f32x4*)(o + 4) = hi; }
};
struct EpiY {
    bf16_t* ga;
    DI void operator()(int z, int m, int n, f32x4 lo, f32x4 hi) const {
        f32x4 a, b;
#pragma unroll
        for (int e = 0; e < 4; ++e) { a[e] = gelu_tanh(lo[e]); b[e] = gelu_tanh(hi[e]); }
        const int t = n >> 4, nn = n & 15;
        *(u32x4*)(ga + ((size_t)(m * 16 + t)) * 1024 + z * 16 + nn) = pk8(a, b);
    }
};
struct EpiGlu {
    const bf16_t* ga; bf16_t* yab; const float* bglu;
    DI void operator()(int, int m, int n, f32x4 lo, f32x4 hi) const {
        const f32x4 b0 = *(const f32x4*)(bglu + n), b1 = *(const f32x4*)(bglu + n + 4);
        f32x4 g0, g1, s0, s1;
        unpk8(*(const u32x4*)(ga + (size_t)m * 1024 + n), g0, g1);
        bf16_t* dst = yab + (size_t)m * 2048 + n;
        unpk8(*(const u32x4*)dst, s0, s1);
        f32x4 o0, o1;
#pragma unroll
        for (int e = 0; e < 4; ++e) { o0[e] = g0[e] * s0[e] / (1.f + __expf(-(lo[e] + b0[e]))); o1[e] = g1[e] * s1[e] / (1.f + __expf(-(hi[e] + b1[e]))); }
        *(u32x4*)dst = pk8(o0, o1);
    }
};
struct EpiRes {
    const float *xa, *xb; int split; const float* gate; bf16_t* zp;
    DI void operator()(int, int m, int n, f32x4 lo, f32x4 hi) const {
        const float* xr = m < split ? xa + (size_t)m * 1024 + n : xb + (size_t)(m - split) * 1024 + n;
        const float* gp = gate + cond_of(m) * 3072 + 2048 + n;
        const f32x4 x0 = *(const f32x4*)xr, x1 = *(const f32x4*)(xr + 4), g0 = *(const f32x4*)gp, g1 = *(const f32x4*)(gp + 4);
        *(u32x4*)(zp + (size_t)m * 1024 + n) = pk8(x0 * ALPHA + g0 * lo, x1 * ALPHA + g1 * hi);
    }
};
struct EpiInO {
    bf16_t *uo, *zo;
    DI void operator()(int, int m, int n, f32x4 lo, f32x4 hi) const {
        if (n < 2048) *(u32x4*)(uo + (size_t)m * 2048 + n) = pk8(lo, hi);
        else {
            f32x4 a, b;
#pragma unroll
            for (int e = 0; e < 4; ++e) { a[e] = siluf(lo[e]); b[e] = siluf(hi[e]); }
            *(u32x4*)(zo + (size_t)m * 2048 + (n - 2048)) = pk8(a, b);
        }
    }
};
struct EpiDftA {
    bf16_t *Tp, *Ts;
    DI void operator()(int z, int m, int n, f32x4 lo, f32x4 hi) const {
        const int cs = m >> 8, j = m & 255;
        const bool pr = n < NPTOK;
        const int sh = pr ? 8 : 10, nn = pr ? n : n - NPTOK, L = 1 << sh, bb = nn >> sh, l = nn & (L - 1);
        *(u32x4*)((pr ? Tp : Ts) + (unsigned)(((bb * 2048 + z * 256 + j) << (sh + 1)) + (cs << sh) + l)) = pk8(lo, hi);
    }
};
struct EpiDftB {
    bf16_t* mixed; int tok0, L;
    DI void operator()(int z, int m, int n, f32x4 lo, f32x4 hi) const { *(u32x4*)(mixed + ((size_t)(tok0 + z * L + m)) * 2048 + n) = pk8(lo, hi); }
};
struct EpiFno {
    const bf16_t* zo; bf16_t* y; const float* bias;
    DI void operator()(int, int m, int n, f32x4 lo, f32x4 hi) const {
        const f32x4 b0 = *(const f32x4*)(bias + n), b1 = *(const f32x4*)(bias + n + 4);
        f32x4 s0, s1; unpk8(*(const u32x4*)(zo + (size_t)m * 2048 + n), s0, s1);
        *(u32x4*)(y + (size_t)m * 2048 + n) = pk8((lo + b0) * s0, (hi + b1) * s1);
    }
};

DI void convert_wt(const float* W, bf16_t* Wt, int K, int N, char* smem, int rot, int p0, int p1) {
    const int half = threadIdx.x >> 8, tid = threadIdx.x & 255;
    float* tile = (float*)(smem + half * 16896);
    const int tn = N / 64, total = (K / 64) * tn, G = gridDim.x;
    int bid = (int)blockIdx.x - rot; bid %= G; if (bid < 0) bid += G;
    for (int t0 = bid * 2; t0 < total; t0 += G * 2) {
        const int t = t0 + half; const bool ok = t < total;
        const int k0 = (t / tn) * 64, n0 = (t % tn) * 64;
        __syncthreads();
        if (ok) { const int r = tid >> 4, c4 = (tid & 15) * 4;
#pragma unroll
          for (int i = 0; i < 4; ++i) { const f32x4 v = *(const f32x4*)(W + (size_t)(k0 + r + 16 * i) * N + n0 + c4);
              float* d = tile + (r + 16 * i) * 65 + c4; d[0] = v[0]; d[1] = v[1]; d[2] = v[2]; d[3] = v[3]; } }
        __syncthreads();
        if (ok) { const int n = tid >> 2, kq = (tid & 3) * 16; u32x4 w0, w1;
          const int rown = n0 + n, src = (rown >= p0 && rown < p1) ? (qk_perm(rown) - n0) : n;
          const float* s = tile + src;
          w0.x = pk2(s[(kq + 0) * 65], s[(kq + 1) * 65]); w0.y = pk2(s[(kq + 2) * 65], s[(kq + 3) * 65]); w0.z = pk2(s[(kq + 4) * 65], s[(kq + 5) * 65]); w0.w = pk2(s[(kq + 6) * 65], s[(kq + 7) * 65]);
          w1.x = pk2(s[(kq + 8) * 65], s[(kq + 9) * 65]); w1.y = pk2(s[(kq + 10) * 65], s[(kq + 11) * 65]); w1.z = pk2(s[(kq + 12) * 65], s[(kq + 13) * 65]); w1.w = pk2(s[(kq + 14) * 65], s[(kq + 15) * 65]);
          bf16_t* d = Wt + (size_t)rown * K + k0 + kq; *(u32x4*)d = w0; *(u32x4*)(d + 8) = w1; }
    }
    __syncthreads();
}

DI void convert_wt_sub(const float* W, bf16_t* Wt, int K, int N, char* smem, int bid, int G, int ldt = 0) {
    const int p0 = 0, p1 = 0;
    const int half = threadIdx.x >> 8, tid = threadIdx.x & 255;
    float* tile = (float*)(smem + half * 16896);
    const int tn = N / 64, total = (K / 64) * tn;
    for (int t0 = bid * 2; t0 < total; t0 += G * 2) {
        const int t = t0 + half; const bool ok = t < total;
        const int k0 = (t / tn) * 64, n0 = (t % tn) * 64;
        __syncthreads();
        if (ok) { const int r = tid >> 4, c4 = (tid & 15) * 4;
#pragma unroll
          for (int i = 0; i < 4; ++i) { const f32x4 v = *(const f32x4*)(W + (size_t)(k0 + r + 16 * i) * N + n0 + c4);
              float* d = tile + (r + 16 * i) * 65 + c4; d[0] = v[0]; d[1] = v[1]; d[2] = v[2]; d[3] = v[3]; } }
        __syncthreads();
        if (ok) { const int n = tid >> 2, kq = (tid & 3) * 16; u32x4 w0, w1;
          const int rown = n0 + n, src = (rown >= p0 && rown < p1) ? (qk_perm(rown) - n0) : n;
          const float* s = tile + src;
          w0.x = pk2(s[(kq + 0) * 65], s[(kq + 1) * 65]); w0.y = pk2(s[(kq + 2) * 65], s[(kq + 3) * 65]); w0.z = pk2(s[(kq + 4) * 65], s[(kq + 5) * 65]); w0.w = pk2(s[(kq + 6) * 65], s[(kq + 7) * 65]);
          w1.x = pk2(s[(kq + 8) * 65], s[(kq + 9) * 65]); w1.y = pk2(s[(kq + 10) * 65], s[(kq + 11) * 65]); w1.z = pk2(s[(kq + 12) * 65], s[(kq + 13) * 65]); w1.w = pk2(s[(kq + 14) * 65], s[(kq + 15) * 65]);
          bf16_t* d = Wt + (size_t)rown * (ldt ? ldt : K) + k0 + kq; *(u32x4*)d = w0; *(u32x4*)(d + 8) = w1; }
    }
    __syncthreads();
}

DI void ssm_params(const Params& p, char* smem, int bid, int nb) {
    const int half = threadIdx.x >> 8, tid = threadIdx.x & 255;
    f32x2* apow = (f32x2*)(smem + half * 51200);
    f32x2* Bb = apow + 2 * 17 * 64;
    f32x2* Cc = Bb + 2 * 64 * 16;
    bf16_t* WS = (bf16_t*)(p.ws + OFF_WS);
    bf16_t* WY = (bf16_t*)(p.ws + OFF_WY);
    for (int j0 = bid * 2; j0 < 128; j0 += nb * 2) {
        const int job = j0 + half, g = job >> 1, dsel = job & 1;
        __syncthreads();
        {
            const int d = tid >> 7, pp = (tid >> 1) & 63, th = tid & 1;
            const float lr = p.lam_re[(d * 64 + g) * 64 + pp], li = p.lam_im[(d * 64 + g) * 64 + pp], dt = expf(p.log_dt[d * 64 + g]);
#pragma unroll 1
            for (int tau = th; tau <= 16; tau += 2) { const float mag = expf(lr * dt * (float)tau); float s, c; sincosf(li * dt * (float)tau, &s, &c); apow[(d * 17 + tau) * 64 + pp] = (f32x2){mag * c, mag * s}; }
            float s1, c1, sh, chh; sincosf(li * dt, &s1, &c1); sincosf(0.5f * li * dt, &sh, &chh);
            const float em1 = expm1f(lr * dt), mag = em1 + 1.f;
            const float arm1 = em1 * c1 - 2.f * sh * sh, ai = mag * s1;
            const float den = lr * lr + li * li;
            const float fr = (arm1 * lr + ai * li) / den, fi = (ai * lr - arm1 * li) / den;
#pragma unroll 1
            for (int m = th * 8; m < th * 8 + 8; ++m) { const float br = p.b_re[((d * 64 + g) * 64 + pp) * 16 + m], bi = p.b_im[((d * 64 + g) * 64 + pp) * 16 + m];
                Bb[(d * 64 + pp) * 16 + m] = (f32x2){fr * br - fi * bi, fr * bi + fi * br}; }
        }
        for (int i = tid; i < 2048; i += 256) { const int d = i >> 10, n = (i >> 6) & 15, pp = i & 63; const size_t gi = ((size_t)(d * 64 + g) * 16 + n) * 64 + pp; Cc[i] = (f32x2){p.c_re[gi], p.c_im[gi]}; }
        __syncthreads();
        bf16_t* wy = WY + (size_t)g * 256 * 512;
        bf16_t* wsg = WS + (size_t)g * 256 * 256;
        {
            const int n = tid >> 4, m = tid & 15, d = dsel;
            float kk[16];
#pragma unroll
            for (int t = 0; t < 16; ++t) kk[t] = 0.f;
            float ko = 0.f;
#pragma unroll 1
            for (int pp = 0; pp < 64; ++pp) {
                const f32x2 cv = Cc[(d * 16 + n) * 64 + pp], bv = Bb[(d * 64 + pp) * 16 + m];
                const float cbr = cv.x * bv.x - cv.y * bv.y, cbi = cv.x * bv.y + cv.y * bv.x;
#pragma unroll
                for (int t = 0; t < 16; ++t) { const f32x2 a = apow[(d * 17 + t) * 64 + pp]; kk[t] += cbr * a.x - cbi * a.y; }
                const f32x2 co = Cc[((d ^ 1) * 16 + n) * 64 + pp], bo = Bb[((d ^ 1) * 64 + pp) * 16 + m];
                ko += co.x * bo.x - co.y * bo.y;
            }
            if (d == 0) {
#pragma unroll
                for (int tau = 1; tau < 16; ++tau) { const bf16_t v = f2bf(kk[tau]);
#pragma unroll 1
                    for (int t = tau; t < 16; ++t) wy[(size_t)(t * 16 + n) * 512 + (t - tau) * 16 + m] = v; }
            } else {
                const bf16_t dv = f2bf(ko + kk[0] + (n == m ? p.ssm_d[g * 16 + n] : 0.f));
#pragma unroll 1
                for (int t = 0; t < 16; ++t) wy[(size_t)(t * 16 + n) * 512 + t * 16 + m] = dv;
#pragma unroll
                for (int tau = 1; tau < 16; ++tau) { const bf16_t v = f2bf(kk[tau]);
#pragma unroll 1
                    for (int t = 0; t + tau < 16; ++t) wy[(size_t)(t * 16 + n) * 512 + (t + tau) * 16 + m] = v; }
            }
        }
        {
            const int d = dsel, c7 = tid & 127, ri = c7 >> 6, pp = c7 & 63, hx = tid >> 7, cidx = d * 128 + c7;
#pragma unroll 1
            for (int row = hx * 128; row < hx * 128 + 128; ++row) {
                const int t = row >> 4, n = row & 15, e = d == 0 ? t + 1 : 16 - t;
                const f32x2 cv = Cc[(d * 16 + n) * 64 + pp], a = apow[(d * 17 + e) * 64 + pp];
                const float v = ri == 0 ? (cv.x * a.x - cv.y * a.y) : -(cv.x * a.y + cv.y * a.x);
                wy[(size_t)row * 512 + 256 + cidx] = f2bf(v);
            }
#pragma unroll 1
            for (int s = hx * 8; s < hx * 8 + 8; ++s) {
                const int e = d == 0 ? 15 - s : s;
                const f32x2 a = apow[(d * 17 + e) * 64 + pp];
                float v[16];
#pragma unroll
                for (int m = 0; m < 16; ++m) { const f32x2 bv = Bb[(d * 64 + pp) * 16 + m]; v[m] = ri == 0 ? (a.x * bv.x - a.y * bv.y) : (a.x * bv.y + a.y * bv.x); }
                u32x4 w0, w1;
                w0.x = pk2(v[0], v[1]); w0.y = pk2(v[2], v[3]); w0.z = pk2(v[4], v[5]); w0.w = pk2(v[6], v[7]);
                w1.x = pk2(v[8], v[9]); w1.y = pk2(v[10], v[11]); w1.z = pk2(v[12], v[13]); w1.w = pk2(v[14], v[15]);
                bf16_t* dd = wsg + (size_t)cidx * 256 + s * 16; *(u32x4*)dd = w0; *(u32x4*)(dd + 8) = w1;
            }
        }
    }
    __syncthreads();
}

DI void mod_gemv(const Params& p, char* smem, int rot) {
    float* sc = (float*)smem;
    float* red = sc + 5 * 1024;
    float* modv = (float*)(p.ws + OFF_MOD);
    const int tid = threadIdx.x;
    int bid = (int)blockIdx.x - rot; bid %= (int)gridDim.x; if (bid < 0) bid += gridDim.x;
    if (bid >= 192) return;
    __syncthreads();
    for (int i = tid; i < 5 * 1024; i += 512) { const int ci = i >> 10, k = i & 1023; const float v = ci == 0 ? p.c_ctx[k] : p.c[(ci - 1) * 1024 + k]; sc[i] = siluf(v); }
    __syncthreads();
    for (int u = bid; u < 192; u += gridDim.x) {
        const int l = u / 96, c0 = (u % 96) * 32, c4 = (tid & 7) * 4, ks = tid >> 3;
        const float* w = p.w_mod + (size_t)l * 1024 * 3072 + c0 + c4;
        f32x4 wv[16];
#pragma unroll
        for (int j = 0; j < 16; ++j) wv[j] = *(const f32x4*)(w + (size_t)(ks * 16 + j) * 3072);
        f32x4 a[5];
#pragma unroll
        for (int ci = 0; ci < 5; ++ci) a[ci] = (f32x4){0.f, 0.f, 0.f, 0.f};
#pragma unroll
        for (int j = 0; j < 16; ++j)
#pragma unroll
            for (int ci = 0; ci < 5; ++ci) a[ci] = a[ci] + wv[j] * sc[ci * 1024 + ks * 16 + j];
#pragma unroll
        for (int ci = 0; ci < 5; ++ci)
#pragma unroll
            for (int e = 0; e < 4; ++e) red[(ks * 32 + c4 + e) * 5 + ci] = a[ci][e];
        __syncthreads();
        if (tid < 160) { const int ci = tid >> 5, cc = tid & 31; float sum = p.b_mod[l * 3072 + c0 + cc];
#pragma unroll 8
            for (int q = 0; q < 64; ++q) sum += red[(q * 32 + cc) * 5 + ci];
            modv[(l * 5 + ci) * 3072 + c0 + cc] = sum; }
        __syncthreads();
    }
}

DI void phase_prep(const Params& p, char* smem) {
    const int tid = threadIdx.x, G = gridDim.x;
    const size_t gt = (size_t)blockIdx.x * 512 + tid, gn = (size_t)G * 512;
    mod_gemv(p, smem, 64);
    convert_wt(p.w_in_e, (bf16_t*)(p.ws + OFF_WINE), 1024, 6144, smem, 0, 2048, 4096);
    { float* rc = (float*)(p.ws + OFF_ROPEC); float* rs = (float*)(p.ws + OFF_ROPES);
      for (size_t i = gt; i < 1024 * 32; i += gn) { const int pos = i >> 5, j = i & 31; const float fq = exp2f(-(float)(j & 15) * (13.287712379549449f / 16.f));
          const float ang = (float)(j < 16 ? (pos >> 6) : (pos & 63)) * fq; float s, c; sincosf(ang, &s, &c); rc[i] = c; rs[i] = s; } }
}
DI void phase_prep_late(const Params& p, char* smem, int bid, int nb) {
    const int tid = threadIdx.x;
    ssm_params(p, smem, bid, nb);
    if (bid < 64) return;
    const size_t gt = (size_t)(bid - 64) * 512 + tid, gn = (size_t)(nb - 64) * 512;
    if (bid == nb - 1 && tid < 64) {
        const float a = wave_sum(p.lq1[tid] * p.lk1[tid]), b = wave_sum(p.lq2[tid] * p.lk2[tid]);
        if (tid == 0) *(float*)(p.ws + OFF_LAM) = expf(a) - expf(b) + LAM_INIT;
    }
    { bf16_t* kS = (bf16_t*)(p.ws + OFF_KS);
      for (size_t i = gt; i < (size_t)4 * 256 * 256; i += gn) {
          const int b = i >> 16, r = i & 65535, pos = r >> 8, c4 = (r & 255) * 4;
          const f32x4 v = *(const f32x4*)(p.cache_k + ((size_t)(b * 256 + pos)) * 1024 + c4);
          *(u32x2*)(kS + ((size_t)(b * 1280 + pos)) * 1024 + c4) = pk4(v); } }
    for (int b = 0; b < 4; ++b)
        convert_wt_sub(p.cache_v + (size_t)b * 256 * 1024, (bf16_t*)(p.ws + OFF_VTS) + (size_t)b * 1024 * 1280, 256, 1024, smem, bid - 64, nb - 64, 1280);
}

DI void phase_prep_later(const Params& p, char* smem, int bid, int nb) {
    const int tid = threadIdx.x;
    const size_t gt = (size_t)bid * 512 + tid, gn = (size_t)nb * 512;
    convert_wt_sub(p.w_out_e, (bf16_t*)(p.ws + OFF_WOUTE), 2048, 1024, smem, bid, nb);
    { bf16_t* W = (bf16_t*)(p.ws + OFF_WDFT);
      for (size_t i = gt; i < 512 * 256; i += gn) { const int c = i & 255, j = (i >> 8) & 255, cs = i >> 16; const float x = 2.f * (float)((j * c) & 255) / 256.f; W[i] = f2bf((cs ? sinpif(x) : cospif(x)) * 0.0625f); } }
    { bf16_t* W = (bf16_t*)(p.ws + OFF_DL256);
      for (size_t i = gt; i < 256 * 512; i += gn) { const int col = i & 511, k = i >> 9, cs = col >> 8, l = col & 255; const float x = 2.f * (float)((k * l) & 255) / 256.f; W[i] = f2bf((cs ? -sinpif(x) : cospif(x)) * 0.0625f); } }
    { bf16_t* W = (bf16_t*)(p.ws + OFF_DL1K);
      for (size_t i = gt; i < 1024 * 2048; i += gn) { const int col = i & 2047, k = i >> 11, cs = col >> 10, l = col & 1023; const float x = 2.f * (float)((k * l) & 1023) / 1024.f; W[i] = f2bf((cs ? -sinpif(x) : cospif(x)) * 0.03125f); } }
}

DI void phase_ln0(const Params& p) {
    const int lane = threadIdx.x & 63, wid = threadIdx.x >> 6;
    const float* modv = (const float*)(p.ws + OFF_MOD);
    bf16_t* h = (bf16_t*)(p.ws + OFF_H0);
    const int stride = gridDim.x * 8;
    f32x4 nv[4];
    { const float* xr = xin(p, blockIdx.x * 8 + wid);
#pragma unroll
      for (int i = 0; i < 4; ++i) nv[i] = *(const f32x4*)(xr + i * 256 + lane * 4); }
    for (int tok = blockIdx.x * 8 + wid; tok < NTOK; tok += stride) {
        f32x4 v[4]; float s = 0.f;
#pragma unroll
        for (int i = 0; i < 4; ++i) v[i] = nv[i];
        if (tok + stride < NTOK) {
            const float* xr = xin(p, tok + stride);
#pragma unroll
            for (int i = 0; i < 4; ++i) nv[i] = *(const f32x4*)(xr + i * 256 + lane * 4);
        }
#pragma unroll
        for (int i = 0; i < 4; ++i) s += v[i][0] + v[i][1] + v[i][2] + v[i][3];
        const float mu = wave_sum(s) * (1.f / 1024.f);
        float q = 0.f;
#pragma unroll
        for (int i = 0; i < 4; ++i) { v[i] = v[i] - mu; q += v[i][0] * v[i][0] + v[i][1] * v[i][1] + v[i][2] * v[i][2] + v[i][3] * v[i][3]; }
        const float rstd = rsqrtf(wave_sum(q) * (1.f / 1024.f) + LN_EPS);
        const float* md = modv + (0 * 5 + cond_of(tok)) * 3072;
#pragma unroll
        for (int i = 0; i < 4; ++i) { const int c = i * 256 + lane * 4; const f32x4 sh = *(const f32x4*)(md + c), sc = *(const f32x4*)(md + 1024 + c);
            *(u32x2*)(h + (size_t)tok * 1024 + c) = pk4(v[i] * rstd * (sc + 1.f) + sh); }
    }
}
DI void phase_ln_mid(const Params& p) {
    const int lane = threadIdx.x & 63, wid = threadIdx.x >> 6;
    const float* modv = (const float*)(p.ws + OFF_MOD);
    const bf16_t* zp = (const bf16_t*)(p.ws + OFF_UCOMB);
    bf16_t* h = (bf16_t*)(p.ws + OFF_H1);
    const int stride = gridDim.x * 8;
    u32x2 nv[4];
    { const bf16_t* xr = zp + (size_t)(blockIdx.x * 8 + wid) * 1024;
#pragma unroll
      for (int i = 0; i < 4; ++i) nv[i] = *(const u32x2*)(xr + i * 256 + lane * 4); }
    for (int tok = blockIdx.x * 8 + wid; tok < NTOK; tok += stride) {
        f32x4 v[4]; float s = 0.f;
#pragma unroll
        for (int i = 0; i < 4; ++i) v[i] = unpk4(nv[i]);
        if (tok + stride < NTOK) {
            const bf16_t* xr = zp + (size_t)(tok + stride) * 1024;
#pragma unroll
            for (int i = 0; i < 4; ++i) nv[i] = *(const u32x2*)(xr + i * 256 + lane * 4);
        }
#pragma unroll
        for (int i = 0; i < 4; ++i) s += v[i][0] + v[i][1] + v[i][2] + v[i][3];
        float mu = wave_sum(s) * (1.f / 1024.f);
        float q = 0.f;
#pragma unroll
        for (int i = 0; i < 4; ++i) { v[i] = v[i] - mu; q += v[i][0] * v[i][0] + v[i][1] * v[i][1] + v[i][2] * v[i][2] + v[i][3] * v[i][3]; }
        float rstd = rsqrtf(wave_sum(q) * (1.f / 1024.f) + LN_EPS);
        s = 0.f;
#pragma unroll
        for (int i = 0; i < 4; ++i) { const int c = i * 256 + lane * 4; const f32x4 gg = *(const f32x4*)(p.ln_g + c), bb = *(const f32x4*)(p.ln_b + c);
            v[i] = v[i] * rstd * gg + bb; *(f32x4*)(p.out + OUT_Y + (size_t)tok * 1024 + c) = v[i]; s += v[i][0] + v[i][1] + v[i][2] + v[i][3]; }
        mu = wave_sum(s) * (1.f / 1024.f); q = 0.f;
#pragma unroll
        for (int i = 0; i < 4; ++i) { v[i] = v[i] - mu; q += v[i][0] * v[i][0] + v[i][1] * v[i][1] + v[i][2] * v[i][2] + v[i][3] * v[i][3]; }
        rstd = rsqrtf(wave_sum(q) * (1.f / 1024.f) + LN_EPS);
        const float* md = modv + (1 * 5 + cond_of(tok)) * 3072;
#pragma unroll
        for (int i = 0; i < 4; ++i) { const int c = i * 256 + lane * 4; const f32x4 sh = *(const f32x4*)(md + c), sc = *(const f32x4*)(md + 1024 + c);
            *(u32x2*)(h + (size_t)tok * 1024 + c) = pk4(v[i] * rstd * (sc + 1.f) + sh); }
    }
}
DI void phase_ln_final(const Params& p) {
    const int lane = threadIdx.x & 63, wid = threadIdx.x >> 6;
    const bf16_t* zp = (const bf16_t*)(p.ws + OFF_UO);
    const int stride = gridDim.x * 8;
    u32x2 nv[4];
    { const bf16_t* xr = zp + (size_t)(blockIdx.x * 8 + wid) * 1024;
#pragma unroll
      for (int i = 0; i < 4; ++i) nv[i] = *(const u32x2*)(xr + i * 256 + lane * 4); }
    for (int tok = blockIdx.x * 8 + wid; tok < NTOK; tok += stride) {
        f32x4 v[4]; float s = 0.f;
#pragma unroll
        for (int i = 0; i < 4; ++i) v[i] = unpk4(nv[i]);
        if (tok + stride < NTOK) {
            const bf16_t* xr = zp + (size_t)(tok + stride) * 1024;
#pragma unroll
            for (int i = 0; i < 4; ++i) nv[i] = *(const u32x2*)(xr + i * 256 + lane * 4);
        }
#pragma unroll
        for (int i = 0; i < 4; ++i) s += v[i][0] + v[i][1] + v[i][2] + v[i][3];
        const float mu = wave_sum(s) * (1.f / 1024.f);
        float q = 0.f;
#pragma unroll
        for (int i = 0; i < 4; ++i) { v[i] = v[i] - mu; q += v[i][0] * v[i][0] + v[i][1] * v[i][1] + v[i][2] * v[i][2] + v[i][3] * v[i][3]; }
        const float rstd = rsqrtf(wave_sum(q) * (1.f / 1024.f) + LN_EPS);
#pragma unroll
        for (int i = 0; i < 4; ++i) { const int c = i * 256 + lane * 4; const f32x4 gg = *(const f32x4*)(p.ln_g + 1024 + c), bb = *(const f32x4*)(p.ln_b + 1024 + c);
            *(f32x4*)(p.out + OUT_Y + (size_t)tok * 1024 + c) = v[i] * rstd * gg + bb; }
    }
}

template <int NI>
DI void carry_items(const Params& p, int g, const int (&seq)[NI], const int (&d)[NI], int pp) {
    const float* S = p.out + OUT_Y;
    bf16_t* ucomb = (bf16_t*)(p.ws + OFF_UCOMB);
    float ar[NI], ai[NI], Hr[NI], Hi[NI]; int chunk0[NI];
    const int nc = seq[0] < 32 ? 16 : 64;
#pragma unroll
    for (int q = 0; q < NI; ++q) {
        const float lr = p.lam_re[(d[q] * 64 + g) * 64 + pp], li = p.lam_im[(d[q] * 64 + g) * 64 + pp], dt = expf(p.log_dt[d[q] * 64 + g]);
        const float mag = expf(16.f * lr * dt); float sn, cs; sincosf(16.f * li * dt, &sn, &cs);
        ar[q] = mag * cs; ai[q] = mag * sn; Hr[q] = 0.f; Hi[q] = 0.f;
        if (seq[q] < 32) chunk0[q] = seq[q] * 16;
        else { const int sb = seq[q] - 32; chunk0[q] = 512 + sb * 64; const int si = ((sb * 2 + d[q]) * 64 + g) * 64 + pp; Hr[q] = p.st_re[si]; Hi[q] = p.st_im[si]; }
    }
    float sr[2][NI][8], si[2][NI][8];
#define CARRY_LOAD(SET, C8) do { _Pragma("unroll") for (int q = 0; q < NI; ++q) _Pragma("unroll") for (int j = 0; j < 8; ++j) { \
        const int chunk = chunk0[q] + (d[q] == 0 ? (C8) + j : nc - 1 - (C8) - j); const size_t row = (size_t)(g * 768 + chunk); \
        sr[SET][q][j] = S[row * 256 + d[q] * 128 + pp]; si[SET][q][j] = S[row * 256 + d[q] * 128 + 64 + pp]; } } while (0)
#define CARRY_STEP(SET, C8) do { _Pragma("unroll") for (int q = 0; q < NI; ++q) _Pragma("unroll") for (int j = 0; j < 8; ++j) { \
        const int chunk = chunk0[q] + (d[q] == 0 ? (C8) + j : nc - 1 - (C8) - j); const size_t row = (size_t)(g * 768 + chunk); \
        ucomb[row * 512 + 256 + d[q] * 128 + pp] = f2bf(Hr[q]); ucomb[row * 512 + 256 + d[q] * 128 + 64 + pp] = f2bf(Hi[q]); \
        const float nr = ar[q] * Hr[q] - ai[q] * Hi[q] + sr[SET][q][j], ni = ar[q] * Hi[q] + ai[q] * Hr[q] + si[SET][q][j]; Hr[q] = nr; Hi[q] = ni; } } while (0)
    CARRY_LOAD(0, 0);
    for (int c8 = 0; c8 < nc; c8 += 16) {
        CARRY_LOAD(1, c8 + 8);
        CARRY_STEP(0, c8);
        if (c8 + 16 < nc) CARRY_LOAD(0, c8 + 16);
        CARRY_STEP(1, c8 + 8);
    }
#undef CARRY_LOAD
#undef CARRY_STEP
#pragma unroll
    for (int q = 0; q < NI; ++q) if (seq[q] < 32) { const int oi = ((seq[q] * 2 + d[q]) * 64 + g) * 64 + pp; p.out[OUT_SR + oi] = Hr[q]; p.out[OUT_SI + oi] = Hi[q]; }
}
DI void carry_local(const Params& p, int g, int pm) {
    const int tid = threadIdx.x;
    if (pm < 2) {
#pragma unroll 1
        for (int h2 = 0; h2 < 2; ++h2) {
            int seq[2], d[2];
#pragma unroll
            for (int j = 0; j < 2; ++j) { const int item = tid + 512 * (2 * h2 + j); seq[j] = pm * 16 + (item >> 7); d[j] = (item >> 6) & 1; }
            carry_items<2>(p, g, seq, d, tid & 63);
        }
    } else { const int seq[1] = {32 + (tid >> 7)}, d[1] = {(tid >> 6) & 1}; carry_items<1>(p, g, seq, d, tid & 63); }
}

DI void phase_attn(const Params& p, char* smem_all) {
    const int team = threadIdx.x >> 8, tid = threadIdx.x & 255, lane = tid & 63, wid = tid >> 6, l31 = lane & 31, hh = lane >> 5;
    const int mp = wid >> 1, qsub = wid & 1;
    char* smem = smem_all + team * 36864;
    bf16_t* sK = (bf16_t*)smem;
    char* sV = smem + 16384;
    float* ex = (float*)smem;
    const bf16_t* Q = (const bf16_t*)(p.ws + OFF_Q);
    bf16_t* yab = (bf16_t*)(p.ws + OFF_YAB);
    const float lam = *(const float*)(p.ws + OFF_LAM);
    const int w = blockIdx.x;
    const int n_it = w < 128 ? 3 : (w < 192 ? 2 : 4);
    for (int it = 0; it < n_it; ++it) {
        const int pair = w < 192 ? (it == 0 ? w : (it == 1 ? 256 + w : 448 + w)) : (it == 0 ? w : 576 + (w - 192) * 3 + (it - 1));
        const int u = pair * 2 + team;
        int hd, Lk, tokq, ldv; const bf16_t *Kb, *Vb;
        if (u < 512) { const int b = u >> 7, r = u & 127; hd = r >> 4; const int qt = r & 15; Lk = 1280; ldv = 1280; tokq = NPTOK + b * 1024 + qt * 64;
            Kb = (const bf16_t*)(p.ws + OFF_KS) + (size_t)b * 1280 * 1024; Vb = (const bf16_t*)(p.ws + OFF_VTS) + (size_t)b * 1024 * 1280; }
        else { const int uu = u - 512, b = uu >> 5, r = uu & 31; hd = r >> 2; const int qt = r & 3; Lk = 256; ldv = 256; tokq = b * 256 + qt * 64;
            Kb = (const bf16_t*)(p.ws + OFF_KP) + (size_t)b * 256 * 1024; Vb = (const bf16_t*)(p.ws + OFF_VTP) + (size_t)b * 1024 * 256; }
        const int tok = tokq + qsub * 32 + l31;
        bf16x8 qf[4];
#pragma unroll
        for (int ks = 0; ks < 4; ++ks) qf[ks] = *(const bf16x8*)(Q + (size_t)tok * 1024 + hd * 128 + mp * 64 + ks * 16 + hh * 8);
        f32x16 o[4];
#pragma unroll
        for (int vb = 0; vb < 4; ++vb)
#pragma unroll
            for (int i = 0; i < 16; ++i) o[vb][i] = 0.f;
        float m_run = -1e30f, l_run = 0.f;
        const int nkt = Lk >> 6;
        u32x4 rk[4], rv[4];
#pragma unroll
        for (int i = 0; i < 4; ++i) { const int idx = tid + 256 * i, mm = idx >> 9, key = (idx >> 3) & 63, ch = idx & 7, vd = idx >> 3;
            rk[i] = *(const u32x4*)(Kb + (size_t)key * 1024 + hd * 128 + mm * 64 + ch * 8);
            rv[i] = *(const u32x4*)(Vb + (size_t)(hd * 128 + vd) * ldv + ch * 8); }
        for (int kt = 0; kt < nkt; ++kt) {
            __syncthreads();
#pragma unroll
            for (int i = 0; i < 4; ++i) { const int idx = tid + 256 * i, mm = idx >> 9, key = (idx >> 3) & 63, ch = idx & 7;
                *(u32x4*)(sK + (mm * 64 + key) * 64 + ((ch ^ (key & 7)) * 8)) = rk[i];
                const int vd = idx >> 3; char* d = sV + vd * 136 + ch * 16;
                *(u32x2*)d = (u32x2){rv[i].x, rv[i].y}; *(u32x2*)(d + 8) = (u32x2){rv[i].z, rv[i].w}; }
            __syncthreads();
            if (kt + 1 < nkt) {
#pragma unroll
                for (int i = 0; i < 4; ++i) { const int idx = tid + 256 * i, mm = idx >> 9, key = (idx >> 3) & 63, ch = idx & 7, vd = idx >> 3;
                    rk[i] = *(const u32x4*)(Kb + (size_t)((kt + 1) * 64 + key) * 1024 + hd * 128 + mm * 64 + ch * 8);
                    rv[i] = *(const u32x4*)(Vb + (size_t)(hd * 128 + vd) * ldv + (kt + 1) * 64 + ch * 8); }
            }
            f32x16 s[2];
#pragma unroll
            for (int kb = 0; kb < 2; ++kb) {
#pragma unroll
                for (int i = 0; i < 16; ++i) s[kb][i] = 0.f;
#pragma unroll
                for (int ks = 0; ks < 4; ++ks) {
                    const bf16x8 kf = *(const bf16x8*)(sK + (mp * 64 + kb * 32 + l31) * 64 + (((ks * 2 + hh) ^ (l31 & 7)) * 8));
                    s[kb] = __builtin_amdgcn_mfma_f32_32x32x16_bf16(kf, qf[ks], s[kb], 0, 0, 0);
                }
            }
            float mx = s[0][0];
#pragma unroll
            for (int i = 0; i < 16; ++i) { mx = fmaxf(mx, s[0][i]); mx = fmaxf(mx, s[1][i]); }
            mx = fmaxf(mx, __shfl_xor(mx, 32));
            const float mnew = fmaxf(m_run, mx);
            const float alpha = __builtin_amdgcn_exp2f((m_run - mnew) * LOG2E);
            const float mneg = -mnew * LOG2E;
            float rs = 0.f;
#pragma unroll
            for (int kb = 0; kb < 2; ++kb)
#pragma unroll
                for (int i = 0; i < 16; ++i) { const float e = __builtin_amdgcn_exp2f(__builtin_fmaf(s[kb][i], LOG2E, mneg)); s[kb][i] = e; rs += e; }
            rs += __shfl_xor(rs, 32);
            l_run = l_run * alpha + rs; m_run = mnew;
#pragma unroll
            for (int vb = 0; vb < 4; ++vb)
#pragma unroll
                for (int i = 0; i < 16; ++i) o[vb][i] *= alpha;
#pragma unroll
            for (int kb = 0; kb < 2; ++kb)
#pragma unroll
                for (int s2 = 0; s2 < 2; ++s2) {
                    u32x4 pw; pw.x = pk2(s[kb][8 * s2], s[kb][8 * s2 + 1]); pw.y = pk2(s[kb][8 * s2 + 2], s[kb][8 * s2 + 3]); pw.z = pk2(s[kb][8 * s2 + 4], s[kb][8 * s2 + 5]); pw.w = pk2(s[kb][8 * s2 + 6], s[kb][8 * s2 + 7]);
                    const bf16x8 pf = __builtin_bit_cast(bf16x8, pw);
#pragma unroll
                    for (int vb = 0; vb < 4; ++vb) {
                        const char* a = sV + (vb * 32 + l31) * 136 + (kb * 32 + 16 * s2 + 4 * hh) * 2;
                        const s16x4 v0 = *(const s16x4*)a, v1 = *(const s16x4*)(a + 16);
                        const bf16x8 vf = __builtin_shufflevector(v0, v1, 0, 1, 2, 3, 4, 5, 6, 7);
                        o[vb] = __builtin_amdgcn_mfma_f32_32x32x16_bf16(vf, pf, o[vb], 0, 0, 0);
                    }
                }
        }
        const float inv = 1.f / l_run;
        __syncthreads();
        if (mp == 1) {
#pragma unroll
            for (int vb = 0; vb < 4; ++vb)
#pragma unroll
                for (int i = 0; i < 16; ++i) ex[(qsub * 128 + vb * 32 + (i & 3) + 8 * (i >> 2) + 4 * hh) * 32 + l31] = o[vb][i] * inv;
        }
        __syncthreads();
        if (mp == 0) {
            float ss = 0.f;
#pragma unroll
            for (int vb = 0; vb < 4; ++vb)
#pragma unroll
                for (int i = 0; i < 16; ++i) { const float v = o[vb][i] * inv - lam * ex[(qsub * 128 + vb * 32 + (i & 3) + 8 * (i >> 2) + 4 * hh) * 32 + l31]; o[vb][i] = v; ss += v * v; }
            ss += __shfl_xor(ss, 32);
            const float rms = rsqrtf(ss * (1.f / 128.f) + LN_EPS) * (1.f - LAM_INIT);
#pragma unroll
            for (int vb = 0; vb < 4; ++vb)
#pragma unroll
                for (int q4 = 0; q4 < 4; ++q4) {
                    const int vd = vb * 32 + 8 * q4 + 4 * hh;
                    const f32x4 gg = *(const f32x4*)(p.subln_g + vd);
                    bf16_t* dst = yab + (size_t)tok * 2048 + 1024 + hd * 128 + vd;
                    const f32x4 sz = unpk4(*(const u32x2*)dst);
                    f32x4 r;
#pragma unroll
                    for (int e = 0; e < 4; ++e) r[e] = o[vb][4 * q4 + e] * rms * gg[e] * sz[e];
                    *(u32x2*)dst = pk4(r);
                }
        }
        __syncthreads();
    }
}
#define XB_TMO      128
#define XB_XCNT(j)  (256  + 64 * (j))
#define XB_XSUB(j)  (1280 + 64 * (j))
#define XB_XGEN(j)  (2304 + 64 * (j))
#define XB_TOP      3328
#define XB_TOPGEN   3392
#define XCD_BAR_WORDS 3456
#define XB_SPIN_CAP (1u << 20)
DI unsigned xb_ld(unsigned* p)              { return __hip_atomic_load(p, __ATOMIC_RELAXED, __HIP_MEMORY_SCOPE_AGENT); }
DI unsigned xb_add(unsigned* p, unsigned v) { return __hip_atomic_fetch_add(p, v, __ATOMIC_RELAXED, __HIP_MEMORY_SCOPE_AGENT); }
DI unsigned xb_xcc_id() { return (unsigned)__builtin_amdgcn_s_getreg((3 << 11) | 20) & 0xFu; }
#define XB_SPIN(cond, bar) do { unsigned _sp = 0; while (cond) { __builtin_amdgcn_s_sleep(1); \
    if ((++_sp & 255u) == 0u) { if (xb_ld(&(bar)[XB_TMO])) break; if (_sp > XB_SPIN_CAP) { atomicAdd(&(bar)[XB_TMO], 1u); break; } } } } while (0)
struct XcdBarrier { unsigned* bar; unsigned x; volatile unsigned* st; };
DI XcdBarrier xb_init(unsigned* bar, volatile unsigned* st) {
    XcdBarrier b; b.bar = bar; b.x = xb_xcc_id(); b.st = st;
    if (threadIdx.x == 0) {
        (void)xb_add(&bar[XB_XCNT(b.x)], 1u);
        const unsigned G = gridDim.x;
        unsigned sum, cnt, mine, sp = 0u;
        for (;;) {
            sum = 0u; cnt = 0u; mine = 0u;
#pragma unroll
            for (unsigned j = 0; j < 16; ++j) { const unsigned c = xb_ld(&bar[XB_XCNT(j)]); sum += c; cnt += (c > 0u) ? 1u : 0u; mine = (j == b.x) ? c : mine; }
            if (sum == G) break;
            __builtin_amdgcn_s_sleep(1);
            if ((++sp & 255u) == 0u) { if (xb_ld(&bar[XB_TMO])) break; if (sp > XB_SPIN_CAP) { atomicAdd(&bar[XB_TMO], 1u); break; } }
        }
        st[0] = mine > 0u ? mine : 1u; st[1] = cnt > 0u ? cnt : 1u;
    }
    return b;
}
DI void xcd_barrier(const XcdBarrier& b) {
    asm volatile("s_waitcnt vmcnt(0)" ::: "memory");
    __syncthreads();
    if (threadIdx.x == 0) {
        unsigned* bar = b.bar;
        __builtin_amdgcn_s_waitcnt(0);
        const unsigned nloc = b.st[0], nx = b.st[1];
        const unsigned old = xb_add(&bar[XB_XSUB(b.x)], 1u);
        const unsigned gen = old / nloc;
        if (old + 1u == (gen + 1u) * nloc) {
            __builtin_amdgcn_fence(__ATOMIC_RELEASE, "agent");
            asm volatile("s_waitcnt vmcnt(0)" ::: "memory");
            const unsigned og = xb_add(&bar[XB_TOP], 1u);
            const unsigned tg = og / nx;
            if (og + 1u == (tg + 1u) * nx) xb_add(&bar[XB_TOPGEN], 1u);
            else XB_SPIN(xb_ld(&bar[XB_TOPGEN]) == tg, bar);
            __builtin_amdgcn_fence(__ATOMIC_ACQUIRE, "agent");
            xb_add(&bar[XB_XGEN(b.x)], 1u);
            asm volatile("s_waitcnt vmcnt(0)" ::: "memory");
        } else {
            XB_SPIN(xb_ld(&bar[XB_XGEN(b.x)]) == gen, bar);
            __builtin_amdgcn_fence(__ATOMIC_ACQUIRE, "agent");
            asm volatile("s_waitcnt vmcnt(0)" ::: "memory");
        }
    }
    __syncthreads();
}

DI void warm_code(unsigned long long base) {
    if (threadIdx.x < 416) {
        const char* a = (const char*)base + ((blockIdx.x >> 3) & 31) * 6656 + threadIdx.x * 16;
        u32x4 t;
        asm volatile("global_load_dwordx4 %0, %1, off\n\ts_waitcnt vmcnt(0)" : "=v"(t) : "v"(a) : "memory");
    }
}

#ifndef ONLY
#define ONLY -1
#endif
#define PHASE(i, ...) if ((ONLY < 0 || ONLY == (i)) && ph_lo <= (i) && (i) < ph_hi) { if ((i) > ph_lo) { warm_code(code_base); xcd_barrier(xb); } __VA_ARGS__ }

constexpr int LDS_BYTES = 147456;
__global__ void __launch_bounds__(512, 2) mega(Params p, int ph_lo, int ph_hi) {
    extern __shared__ __attribute__((aligned(16))) unsigned char lds_raw[];
    PG8_LAS unsigned char* lds = (PG8_LAS unsigned char*)lds_raw;
    char* smem = (char*)lds_raw;
    cg::grid_group grid = cg::this_grid();
    char* ws = p.ws;
    if (ph_lo < 0) grid.sync();
    unsigned long long code_base = __builtin_amdgcn_s_getpc() & ~0xFFFull;
    asm volatile("" : "+s"(code_base));
    warm_code(code_base);
    const XcdBarrier xb = xb_init((unsigned*)(ws + OFF_BAR), (volatile unsigned*)(lds_raw + LDS_BYTES - 16));
    const float* modv = (const float*)(ws + OFF_MOD);
    PHASE(0, { if (blockIdx.x < 64) convert_wt_sub(p.w_glu, (bf16_t*)(ws + OFF_WGLU), 1024, 1024, smem, (int)blockIdx.x, 64);
               phase_prep(p, smem); })
    PHASE(1, { phase_ln0(p); })
    PHASE(2, {
        GemmDesc g{(const bf16_t*)(ws + OFF_H0), (const bf16_t*)(ws + OFF_WINE), 0, 0, 1024, 1024, NTOK, 6144, 1024, 1};
        EpiInE e{(bf16_t*)(ws + OFF_UCOMB), (bf16_t*)(ws + OFF_YAB), (bf16_t*)(ws + OFF_Q), (bf16_t*)(ws + OFF_KP), (bf16_t*)(ws + OFF_KS), (bf16_t*)(ws + OFF_VTP), (bf16_t*)(ws + OFF_VTS), p.out,
                 (const float*)(ws + OFF_ROPEC), (const float*)(ws + OFF_ROPES)};
        gemm_run(g, e, lds);
        if (blockIdx.x >= 128) phase_prep_late(p, smem, (int)blockIdx.x - 128, 128); })
    PHASE(3, {
        { GemmDesc g{(const bf16_t*)(ws + OFF_UCOMB), (const bf16_t*)(ws + OFF_WS), 768L * 512, 256L * 256, 512, 256, 768, 256, 256, 64};
          EpiS e{p.out + OUT_Y};
          gemm_run(g, e, lds); }
        __threadfence_block(); __syncthreads();
        if (blockIdx.x < 192) carry_local(p, (int)blockIdx.x / 3, (int)blockIdx.x % 3);
        __threadfence_block(); __syncthreads();
        { GemmDesc g{(const bf16_t*)(ws + OFF_UCOMB), (const bf16_t*)(ws + OFF_WY), 768L * 512, 256L * 512, 512, 512, 768, 256, 512, 64};
          EpiY e{(bf16_t*)(ws + OFF_H0)};
          gemm_run(g, e, lds); }
        phase_attn(p, smem); })
    PHASE(4, {
        GemmDesc g{(const bf16_t*)(ws + OFF_H0), (const bf16_t*)(ws + OFF_WGLU), 0, 0, 1024, 1024, NTOK, 1024, 1024, 1};
        EpiGlu e{(const bf16_t*)(ws + OFF_H0), (bf16_t*)(ws + OFF_YAB), p.b_glu};
        gemm_run(g, e, lds);
        if (blockIdx.x >= 192) { phase_prep_later(p, smem, (int)blockIdx.x - 192, 64);
            convert_wt_sub(p.w_out_o, (bf16_t*)(ws + OFF_WOUTO), 2048, 1024, smem, (int)blockIdx.x - 192, 64); } })
    PHASE(5, {
        GemmDesc g{(const bf16_t*)(ws + OFF_YAB), (const bf16_t*)(ws + OFF_WOUTE), 0, 0, 2048, 2048, NTOK, 1024, 2048, 1};
        EpiRes e{p.x_prompt, p.x_sample, NPTOK, modv, (bf16_t*)(ws + OFF_UCOMB)};
        gemm_run(g, e, lds);
        if (blockIdx.x >= 192) {
            convert_wt_sub(p.w_in_o, (bf16_t*)(ws + OFF_WINO), 1024, 4096, smem, (int)blockIdx.x - 192, 64);
            convert_wt_sub(p.w_fno, (bf16_t*)(ws + OFF_WFNO), 2048, 2048, smem, (int)blockIdx.x - 192, 64);
 } })
    PHASE(6, { phase_ln_mid(p); })
    PHASE(7, {
        GemmDesc g{(const bf16_t*)(ws + OFF_H1), (const bf16_t*)(ws + OFF_WINO), 0, 0, 1024, 1024, NTOK, 4096, 1024, 1};
        EpiInO e{(bf16_t*)(ws + OFF_UO), (bf16_t*)(ws + OFF_ZO)};
        gemm_run(g, e, lds); })
    PHASE(8, {
        GemmDesc g{(const bf16_t*)(ws + OFF_WDFT), (const bf16_t*)(ws + OFF_UO), 0, 256, 256, 2048, 512, NTOK, 256, 8};
        EpiDftA e{(bf16_t*)(ws + OFF_TP), (bf16_t*)(ws + OFF_TS)};
        gemm_run(g, e, lds); })
    PHASE(9, {
        { GemmDesc g{(const bf16_t*)(ws + OFF_DL1K), (const bf16_t*)(ws + OFF_TS), 0, 2048L * 2048, 2048, 2048, 1024, 2048, 2048, 4};
          EpiDftB e{(bf16_t*)(ws + OFF_UO), NPTOK, 1024};
          gemm_run(g, e, lds); }
        { GemmDesc g{(const bf16_t*)(ws + OFF_DL256), (const bf16_t*)(ws + OFF_TP), 0, 2048L * 512, 512, 512, 256, 2048, 512, 32};
          EpiDftB e{(bf16_t*)(ws + OFF_UO), 0, 256};
          gemm_run(g, e, lds, 128, 128); } })
    PHASE(10, {
        GemmDesc g{(const bf16_t*)(ws + OFF_UO), (const bf16_t*)(ws + OFF_WFNO), 0, 0, 2048, 2048, NTOK, 2048, 2048, 1};
        EpiFno e{(const bf16_t*)(ws + OFF_ZO), (bf16_t*)(ws + OFF_Y1), p.b_fno};
        gemm_run(g, e, lds); })
    PHASE(11, {
        GemmDesc g{(const bf16_t*)(ws + OFF_Y1), (const bf16_t*)(ws + OFF_WOUTO), 0, 0, 2048, 2048, NTOK, 1024, 2048, 1};
        EpiRes e{p.out + OUT_Y, p.out + OUT_Y, NTOK, modv + 5 * 3072, (bf16_t*)(ws + OFF_UO)};
        gemm_run(g, e, lds); })
    PHASE(12, { phase_ln_final(p); })
}

extern "C" void kernel_launch(void* const* d_in, const int* in_sizes, int n_in, void* d_out, int out_size, void* d_ws, size_t ws_size, hipStream_t stream) {
    (void)in_sizes; (void)n_in; (void)out_size; (void)ws_size;
    Params p{};
    const float** f = (const float**)&p;
    for (int i = 0; i < 33; ++i) f[i] = (const float*)d_in[i];
    p.out = (float*)d_out; p.ws = (char*)d_ws;
    static int grid_blocks = 0;
    if (!grid_blocks) {
        int dev = 0, cus = 0, per_cu = 0;
        (void)hipGetDevice(&dev);
        (void)hipDeviceGetAttribute(&cus, hipDeviceAttributeMultiprocessorCount, dev);
        (void)hipFuncSetAttribute((const void*)mega, hipFuncAttributeMaxDynamicSharedMemorySize, LDS_BYTES);
        (void)hipOccupancyMaxActiveBlocksPerMultiprocessor(&per_cu, mega, 512, LDS_BYTES);
        if (per_cu > 1) per_cu = 1;
        if (per_cu < 1) per_cu = 1;
        grid_blocks = cus * per_cu;
    }
    (void)hipMemsetAsync((char*)d_ws + OFF_BAR, 0, XCD_BAR_WORDS * sizeof(unsigned), stream);
    int lo = 0, hi = 13;
    void* args[] = {&p, &lo, &hi};
    hipError_t e = hipLaunchCooperativeKernel((void*)mega, dim3(grid_blocks), dim3(512), args, LDS_BYTES, stream);
    if (e != hipSuccess) fprintf(stderr, "cooperative launch failed: %s (grid %d)\n", hipGetErrorString(e), grid_blocks);
}
```

```cpp
#include <hip/hip_runtime.h>
#include <hip/hip_cooperative_groups.h>
#include <cstdio>
#include <cstdint>
namespace cg = cooperative_groups;

typedef unsigned short bf16_t;
typedef short bf16x8 __attribute__((ext_vector_type(8)));
typedef short s16x4 __attribute__((ext_vector_type(4)));
typedef float f32x4 __attribute__((ext_vector_type(4)));
typedef float f32x2 __attribute__((ext_vector_type(2)));
typedef float f32x16 __attribute__((ext_vector_type(16)));
typedef unsigned u32x4 __attribute__((ext_vector_type(4)));
typedef unsigned u32x2 __attribute__((ext_vector_type(2)));
typedef __bf16 bfv2 __attribute__((ext_vector_type(2)));

#define DI __device__ __forceinline__

constexpr int NTOK = 12288, NPTOK = 8192, DM = 1024;
constexpr float LN_EPS = 1e-5f;
constexpr float ALPHA = 1.41421356237f;
constexpr float LAM_INIT = 0.2f;
constexpr float LOG2E = 1.4426950408889634f;

constexpr size_t MiB = 1024ull * 1024ull;
constexpr size_t OFF_MOD   = 0;
constexpr size_t OFF_ROPEC = 256 * 1024;
constexpr size_t OFF_ROPES = 384 * 1024;
constexpr size_t OFF_LAM   = 512 * 1024;
constexpr size_t OFF_BAR   = 1024 * 1024;
constexpr size_t OFF_WDFT  = 2 * MiB;
constexpr size_t OFF_DL256 = 2 * MiB + 256 * 1024;
constexpr size_t OFF_DL1K  = 3 * MiB;
constexpr size_t OFF_WINE  = 8 * MiB;
constexpr size_t OFF_WGLU  = 20 * MiB;
constexpr size_t OFF_WOUTE = 22 * MiB;
constexpr size_t OFF_WS    = 26 * MiB;
constexpr size_t OFF_WY    = 34 * MiB;
constexpr size_t OFF_H0    = 50 * MiB;
constexpr size_t OFF_UCOMB = 74 * MiB;
constexpr size_t OFF_YAB   = 122 * MiB;
constexpr size_t OFF_Q     = 170 * MiB;
constexpr size_t OFF_KP    = 194 * MiB;
constexpr size_t OFF_KS    = 210 * MiB;
constexpr size_t OFF_VTP   = 220 * MiB;
constexpr size_t OFF_VTS   = 236 * MiB;
constexpr size_t OFF_WINO  = 8 * MiB;
constexpr size_t OFF_WFNO  = 26 * MiB;
constexpr size_t OFF_WOUTO = 16 * MiB;
constexpr size_t OFF_H1    = 34 * MiB;
constexpr size_t OFF_UO    = 58 * MiB;
constexpr size_t OFF_ZO    = 106 * MiB;
constexpr size_t OFF_TP    = 154 * MiB;
constexpr size_t OFF_TS    = 218 * MiB;
constexpr size_t OFF_Y1    = 154 * MiB;
constexpr size_t OUT_Y  = 0;
constexpr size_t OUT_CK = 12582912;
constexpr size_t OUT_CV = 20971520;
constexpr size_t OUT_SR = 29360128;
constexpr size_t OUT_SI = 29622272;

struct Params {
    const float *x_prompt, *x_sample, *cache_k, *cache_v, *st_re, *st_im, *c, *c_ctx, *w_mod, *b_mod, *ln_g, *ln_b, *w_in_e,
        *lam_re, *lam_im, *log_dt, *b_re, *b_im, *c_re, *c_im, *ssm_d, *w_glu, *b_glu, *lq1, *lk1, *lq2, *lk2, *subln_g, *w_out_e,
        *w_in_o, *w_fno, *b_fno, *w_out_o;
    float* out;
    char* ws;
};

DI float bf2f(bf16_t b) { return __uint_as_float(((unsigned)b) << 16); }
DI unsigned pk2(float lo, float hi) { f32x2 v = {lo, hi}; bfv2 b = __builtin_convertvector(v, bfv2); return __builtin_bit_cast(unsigned, b); }
DI bf16_t f2bf(float x) { return (bf16_t)(pk2(x, 0.f) & 0xffffu); }
DI u32x2 pk4(f32x4 v) { u32x2 r; r.x = pk2(v[0], v[1]); r.y = pk2(v[2], v[3]); return r; }
DI f32x4 unpk4(u32x2 r) { f32x4 v; v[0] = __uint_as_float(r.x << 16); v[1] = __uint_as_float(r.x & 0xffff0000u); v[2] = __uint_as_float(r.y << 16); v[3] = __uint_as_float(r.y & 0xffff0000u); return v; }
DI float siluf(float x) { return x / (1.f + __expf(-x)); }
DI float gelu_tanh(float x) { float u = 0.7978845608028654f * (x + 0.044715f * x * x * x); float e = __expf(2.f * u); return 0.5f * x * (2.f - 2.f / (1.f + e)); }
DI float wave_sum(float v) {
#pragma unroll
    for (int o = 32; o; o >>= 1) v += __shfl_xor(v, o);
    return v;
}
DI int cond_of(int tok) { return tok < NPTOK ? 0 : 1 + ((tok - NPTOK) >> 10); }
DI const float* xin(const Params& p, int tok) { return tok < NPTOK ? p.x_prompt + (size_t)tok * DM : p.x_sample + (size_t)(tok - NPTOK) * DM; }

#define PG8_LAS __attribute__((address_space(3)))
namespace pg8 {
constexpr int BM = 256, BK = 64, HALF = 128, HTB = HALF * BK * 2, STAGE_BYTES = 8 * HTB, NXCD = 8, WGM = 2;
DI int lds_byte(int r, int c) { const int st = (r >> 4) * 2 + (c >> 5), rr = r & 15, cc = c & 31, ob = rr * 64 + cc * 2; return st * 1024 + (ob ^ (((ob >> 9) & 1) << 5)); }
DI void stage_rc(int b, int& R, int& C) { const int st = b / 1024, sb = b % 1024, swz = sb ^ (((sb >> 9) & 1) << 5); R = (st >> 1) * 16 + swz / 64; C = (st & 1) * 32 + (swz % 64) / 2; }
DI int perm32(int rho) { const int n = rho >> 4, i = rho & 15; return 8 * (i >> 2) + 4 * n + (i & 3); }
struct Unit { int pm, pn, z; };
struct Gemm { const bf16_t* A; const bf16_t* Bt; long az, bz; int lda, ldb, M, N, K, Z; };
struct Order {
    int nM, nN, nwg, total, G, c, Z;
    DI void init(int M, int N, int Z_, int G_, int c_) { nM = M / BM; nN = N / BM; nwg = nM * nN; Z = Z_; total = nwg * Z_; G = G_; c = c_; }
    DI bool next(int i, Unit& u) const {
        const int L = i * G + c; if (L >= total) return false;
        if (Z == 1) {
            int wgid = L; { const int q = nwg / NXCD, r = nwg % NXCD, xcd = wgid % NXCD, off = wgid / NXCD; wgid = (xcd < r ? xcd * (q + 1) : r * (q + 1) + (xcd - r) * q) + off; }
            const int nig = WGM * nN, gid = wgid / nig, fm = gid * WGM, gsz = (nM - fm) < WGM ? (nM - fm) : WGM;
            u.pm = fm + ((wgid % nig) % gsz); u.pn = (wgid % nig) / gsz; u.z = 0;
        } else { const int z = (int)((unsigned)L / (unsigned)nwg), r = L - z * nwg; u.z = z; u.pm = r % nM; u.pn = r / nM; }
        return true;
    }
    DI void a_ready(const Unit&) const {}
    DI void done(const Unit&) const {}
};
template <class F> struct Epi {
    static constexpr bool PERM = true, AFTER_DRAIN = false;
    F f;
    DI void operator()(const f32x4 (&acc)[2][2][4][2], const Unit& u, int wr, int wc, int fr, int fq) const {
#pragma unroll
        for (int ai = 0; ai < 2; ++ai)
#pragma unroll
            for (int m = 0; m < 4; ++m) {
                const int row = u.pm * BM + ai * HALF + wr * 64 + m * 16 + fr;
#pragma unroll
                for (int bj = 0; bj < 2; ++bj) f(u.z, row, u.pn * BM + bj * HALF + wc * 32 + 8 * fq, acc[ai][bj][m][0], acc[ai][bj][m][1]);
                asm volatile("" ::: "memory");
            }
    }
};
template <class EpiT, class Sched, bool ALIGN_EPI = true>
DI void gemm_phase(PG8_LAS unsigned char* lds, const Gemm g, const Sched& S, const EpiT& E) {
    const int tid = threadIdx.x, wid = __builtin_amdgcn_readfirstlane(tid >> 6), lane = tid & 63, wr = wid >> 2, wc = wid & 3, fr = lane & 15, fq = lane >> 4;
    const int K = g.K, nt = K / BK;
    unsigned voffA, voffB;
    { int R, C; stage_rc(tid * 16, R, C); const int Rb = EpiT::PERM ? ((R & ~31) + perm32(R & 31)) : R; voffA = (unsigned)(R * g.lda + C) * 2u; voffB = (unsigned)(Rb * g.ldb + C) * 2u; }
    const size_t r64voffA = (size_t)64 * g.lda * 2, r64voffB = (size_t)64 * g.ldb * 2;
    const size_t kstep = (size_t)(BK * 2);
    const size_t hstepA = (size_t)HALF * g.lda * 2, hstepB = (size_t)HALF * g.ldb * 2;
    const size_t tstepA = 2 * hstepA, tstepB = 2 * hstepB;
    const unsigned ldsw = (unsigned)wid * 1024u;
    const int aoff = lds_byte(wr * 64 + fr, fq * 8), boff = lds_byte(wc * 32 + fr, fq * 8);
#define PG8_SA(b, h) (((b) * 2 + (h)) * HTB)
#define PG8_SB(b, h) ((4 + (b) * 2 + (h)) * HTB)
#define PG8_STAGE(bufoff, gbase, voff) do { \
        __builtin_amdgcn_global_load_lds((const unsigned*)((const char*)(gbase) + (voff)), (PG8_LAS unsigned*)(lds + (bufoff) + ldsw), 16, 0, 0); \
        __builtin_amdgcn_global_load_lds((const unsigned*)((const char*)(gbase) + r64##voff + (voff)), (PG8_LAS unsigned*)(lds + (bufoff) + ldsw + 8192), 16, 0, 0); } while (0)
#define PG8_LDA(dst, b, h) do { _Pragma("unroll") for (int m = 0; m < 4; ++m) _Pragma("unroll") for (int k = 0; k < 2; ++k) dst[m][k] = *(const PG8_LAS bf16x8*)(lds + PG8_SA(b, h) + aoff + m * 2048 + k * 1024); } while (0)
#define PG8_LDB(dst, b, h) do { _Pragma("unroll") for (int n = 0; n < 2; ++n) _Pragma("unroll") for (int k = 0; k < 2; ++k) dst[n][k] = *(const PG8_LAS bf16x8*)(lds + PG8_SB(b, h) + boff + n * 2048 + k * 1024); } while (0)
#define PG8_MMA(ai, bj, At, Bt) do { __builtin_amdgcn_s_setprio(1); _Pragma("unroll") for (int m = 0; m < 4; ++m) _Pragma("unroll") for (int n = 0; n < 2; ++n) _Pragma("unroll") for (int k = 0; k < 2; ++k) \
        acc[ai][bj][m][n] = __builtin_amdgcn_mfma_f32_16x16x32_bf16(Bt[n][k], At[m][k], acc[ai][bj][m][n], 0, 0, 0); __builtin_amdgcn_s_setprio(0); } while (0)
#define PG8_WAIT_V(n) asm volatile("s_waitcnt vmcnt(" #n ")" ::: "memory")
#define PG8_WAIT_L(n) asm volatile("s_waitcnt lgkmcnt(" #n ")" ::: "memory")
#define PG8_BAR __builtin_amdgcn_s_barrier()
#define PG8_SCHED __builtin_amdgcn_sched_barrier(0)
    Unit cur, nxt; int ui = 0;
    if (!S.next(0, cur)) return;
    f32x4 acc[2][2][4][2];
#pragma unroll
    for (int a = 0; a < 2; ++a)
#pragma unroll
        for (int b = 0; b < 2; ++b)
#pragma unroll
            for (int m = 0; m < 4; ++m)
#pragma unroll
                for (int n = 0; n < 2; ++n) acc[a][b][m][n] = (f32x4){0.f, 0.f, 0.f, 0.f};
    bf16x8 At[4][2], B0[2][2], B1[2][2];
    const char* cA = (const char*)g.A + (size_t)cur.z * g.az * 2 + (size_t)cur.pm * tstepA; const char* cB = (const char*)g.Bt + (size_t)cur.z * g.bz * 2 + (size_t)cur.pn * tstepB;
    S.a_ready(cur);
    PG8_STAGE(PG8_SB(0, 0), cB, voffB); PG8_STAGE(PG8_SB(0, 1), cB + hstepB, voffB); PG8_STAGE(PG8_SA(0, 0), cA, voffA); PG8_STAGE(PG8_SA(0, 1), cA + hstepA, voffA);
    if (wr == 1) PG8_BAR;
    PG8_WAIT_V(2); PG8_BAR;
    PG8_STAGE(PG8_SB(1, 0), cB + kstep, voffB); PG8_STAGE(PG8_SA(1, 0), cA + kstep, voffA); PG8_STAGE(PG8_SB(1, 1), cB + hstepB + kstep, voffB);
    PG8_WAIT_V(6); PG8_BAR;
    for (;;) {
        const bool has_next = S.next(ui + 1, nxt);
        const char* nA = has_next ? (const char*)g.A + (size_t)nxt.z * g.az * 2 + (size_t)nxt.pm * tstepA : cA; const char* nB = has_next ? (const char*)g.Bt + (size_t)nxt.z * g.bz * 2 + (size_t)nxt.pn * tstepB : cB;
#pragma unroll 1
        for (int t = 0; t < nt; t += 2) {
            const bool last = (t == nt - 2);
            const char* a1 = cA + (size_t)(t + 1) * kstep;
            const char* a2 = last ? nA : cA + (size_t)(t + 2) * kstep; const char* b2 = last ? nB : cB + (size_t)(t + 2) * kstep;
            const char* a3 = a2 + kstep; const char* b3 = b2 + kstep;
            if (last && has_next) S.a_ready(nxt);
            PG8_LDB(B0, 0, 0); PG8_LDB(B1, 0, 1); PG8_SCHED; PG8_LDA(At, 0, 0); PG8_STAGE(PG8_SA(1, 1), a1 + hstepA, voffA);
            PG8_WAIT_V(8); PG8_WAIT_L(0); PG8_BAR; PG8_MMA(0, 0, At, B0); PG8_MMA(0, 1, At, B1); PG8_BAR; PG8_SCHED;
            PG8_LDA(At, 0, 1); PG8_STAGE(PG8_SB(0, 0), b2, voffB); PG8_STAGE(PG8_SB(0, 1), b2 + hstepB, voffB); PG8_STAGE(PG8_SA(0, 0), a2, voffA);
            PG8_WAIT_V(8); PG8_WAIT_L(0); PG8_BAR; PG8_MMA(1, 0, At, B0); PG8_MMA(1, 1, At, B1); PG8_BAR; PG8_SCHED;
            PG8_LDB(B0, 1, 0); PG8_LDB(B1, 1, 1); PG8_SCHED; PG8_LDA(At, 1, 0); PG8_STAGE(PG8_SA(0, 1), a2 + hstepA, voffA);
            PG8_WAIT_V(8); PG8_WAIT_L(0); PG8_BAR; PG8_MMA(0, 0, At, B0); PG8_MMA(0, 1, At, B1); PG8_BAR; PG8_SCHED;
            PG8_LDA(At, 1, 1); PG8_STAGE(PG8_SB(1, 0), b3, voffB); PG8_STAGE(PG8_SB(1, 1), b3 + hstepB, voffB); PG8_STAGE(PG8_SA(1, 0), a3, voffA);
            PG8_WAIT_V(8); PG8_WAIT_L(0); PG8_BAR; PG8_MMA(1, 0, At, B0); PG8_MMA(1, 1, At, B1); PG8_BAR; PG8_SCHED;
        }
        if constexpr (ALIGN_EPI) { if (wr == 0) PG8_BAR; }
        E(acc, cur, wr, wc, fr, fq); S.done(cur);
        if (!has_next) break;
#pragma unroll
        for (int a = 0; a < 2; ++a)
#pragma unroll
            for (int b = 0; b < 2; ++b)
#pragma unroll
                for (int m = 0; m < 4; ++m)
#pragma unroll
                    for (int n = 0; n < 2; ++n) acc[a][b][m][n] = (f32x4){0.f, 0.f, 0.f, 0.f};
        cur = nxt; cA = nA; cB = nB; ++ui;
        if constexpr (ALIGN_EPI) { if (wr == 1) PG8_BAR; }
    }
    PG8_WAIT_V(0);
    if constexpr (!ALIGN_EPI) { if (wr == 0) PG8_BAR; }
    PG8_BAR;
#undef PG8_SA
#undef PG8_SB
#undef PG8_STAGE
#undef PG8_LDA
#undef PG8_LDB
#undef PG8_MMA
#undef PG8_WAIT_V
#undef PG8_WAIT_L
#undef PG8_BAR
#undef PG8_SCHED
}
}
typedef pg8::Gemm GemmDesc;
template <class F>
DI void gemm_run(const GemmDesc g, const F f, PG8_LAS unsigned char* lds, int wg0 = 0, int nwg = 0) {
    if (nwg == 0) nwg = (int)gridDim.x;
    const int c = (int)blockIdx.x - wg0;
    pg8::Order S; S.init(g.M, g.N, g.Z, nwg, c);
    if (c < 0 || c >= nwg) { S.total = 0; S.c = 0; }
    const pg8::Epi<F> E{f};
    pg8::gemm_phase<pg8::Epi<F>, pg8::Order, true>(lds, g, S, E);
    __syncthreads();
}

DI u32x4 pk8(f32x4 a, f32x4 b) { u32x4 r; r.x = pk2(a[0], a[1]); r.y = pk2(a[2], a[3]); r.z = pk2(b[0], b[1]); r.w = pk2(b[2], b[3]); return r; }
DI void unpk8(u32x4 r, f32x4& a, f32x4& b) { a = unpk4((u32x2){r.x, r.y}); b = unpk4((u32x2){r.z, r.w}); }
DI int qk_perm(int c) { const int c6 = c & 63; return (c & ~63) + 32 * ((c6 >> 2) & 1) + 4 * (c6 >> 3) + (c6 & 3); }
struct EpiInE {
    bf16_t *ucomb, *yab, *q, *kP, *kS, *vTP, *vTS; float* out; const float *rc, *rs;
    DI void operator()(int, int m, int n, f32x4 lo, f32x4 hi) const {
        const int seg = n >> 10, nn = n & 1023;
        const bool samp = m >= NPTOK;
        if (seg == 0) {
            const int chunk = m >> 4, t = m & 15, g = nn >> 4, mm = nn & 15;
            *(u32x4*)(ucomb + ((size_t)(g * 768 + chunk) * 512 + t * 16 + mm)) = pk8(lo, hi);
        } else if (seg == 1 || seg == 5) {
            f32x4 a, b;
#pragma unroll
            for (int e = 0; e < 4; ++e) { a[e] = siluf(lo[e]); b[e] = siluf(hi[e]); }
            *(u32x4*)(yab + (size_t)m * 2048 + (seg == 5 ? 1024 : 0) + nn) = pk8(a, b);
        } else if (seg == 2 || seg == 3) {
            const int j0 = (nn & 63) >> 1, ft = (nn & ~63) + j0;
            if (!samp && seg == 3) { float* o = out + OUT_CK + (size_t)m * 1024 + ft; *(f32x4*)o = lo; *(f32x4*)(o + 32) = hi; }
            if (samp) {
                const int pos = (m - NPTOK) & 1023;
                const f32x4 cs = *(const f32x4*)(rc + pos * 32 + j0), sn = *(const f32x4*)(rs + pos * 32 + j0);
                const f32x4 a = lo * cs - hi * sn, b = lo * sn + hi * cs; lo = a; hi = b;
            }
            if (seg == 2) { lo = lo * 0.125f; hi = hi * 0.125f; bf16_t* dst = q + (size_t)m * 1024 + ft; *(u32x2*)dst = pk4(lo); *(u32x2*)(dst + 32) = pk4(hi); }
            else {
                bf16_t* dst;
                if (!samp) dst = kP + (size_t)m * 1024 + ft;
                else { const int b = (m - NPTOK) >> 10, pos = (m - NPTOK) & 1023; dst = kS + ((size_t)(b * 1280 + 256 + pos)) * 1024 + ft; }
                *(u32x2*)dst = pk4(lo); *(u32x2*)(dst + 32) = pk4(hi);
            }
        } else {
            if (!samp) {
                float* o = out + OUT_CV + (size_t)m * 1024 + nn; *(f32x4*)o = lo; *(f32x4*)(o + 4) = hi;
                const int b = m >> 8, pos = m & 255;
                bf16_t* dst = vTP + ((size_t)(b * 1024 + nn)) * 256 + pos;
#pragma unroll
                for (int e = 0; e < 4; ++e) { dst[(size_t)e * 256] = f2bf(lo[e]); dst[(size_t)(e + 4) * 256] = f2bf(hi[e]); }
            } else {
                const int b = (m - NPTOK) >> 10, pos = (m - NPTOK) & 1023;
                bf16_t* dst = vTS + ((size_t)(b * 1024 + nn)) * 1280 + 256 + pos;
#pragma unroll
                for (int e = 0; e < 4; ++e) { dst[(size_t)e * 1280] = f2bf(lo[e]); dst[(size_t)(e + 4) * 1280] = f2bf(hi[e]); }
            }
        }
    }
};
struct EpiS {
    float* S;
    DI void operator()(int z, int m, int n, f32x4 lo, f32x4 hi) const { float* o = S + ((size_t)(z * 768 + m)) * 256 + n; *(f32x4*)o = lo; *(f32x4*)(o + 4) = hi; }
};
struct EpiY {
    bf16_t* ga;
    DI void operator()(int z, int m, int n, f32x4 lo, f32x4 hi) const {
        f32x4 a, b;
#pragma unroll
        for (int e = 0; e < 4; ++e) { a[e] = gelu_tanh(lo[e]); b[e] = gelu_tanh(hi[e]); }
        const int t = n >> 4, nn = n & 15;
        *(u32x4*)(ga + ((size_t)(m * 16 + t)) * 1024 + z * 16 + nn) = pk8(a, b);
    }
};
struct EpiGlu {
    const bf16_t* ga; bf16_t* yab; const float* bglu;
    DI void operator()(int, int m, int n, f32x4 lo, f32x4 hi) const {
        const f32x4 b0 = *(const f32x4*)(bglu + n), b1 = *(const f32x4*)(bglu + n + 4);
        f32x4 g0, g1, s0, s1;
        unpk8(*(const u32x4*)(ga + (size_t)m * 1024 + n), g0, g1);
        bf16_t* dst = yab + (size_t)m * 2048 + n;
        unpk8(*(const u32x4*)dst, s0, s1);
        f32x4 o0, o1;
#pragma unroll
        for (int e = 0; e < 4; ++e) { o0[e] = g0[e] * s0[e] / (1.f + __expf(-(lo[e] + b0[e]))); o1[e] = g1[e] * s1[e] / (1.f + __expf(-(hi[e] + b1[e]))); }
        *(u32x4*)dst = pk8(o0, o1);
    }
};
struct EpiRes {
    const float *xa, *xb; int split; const float* gate; bf16_t* zp;
    DI void operator()(int, int m, int n, f32x4 lo, f32x4 hi) const {
        const float* xr = m < split ? xa + (size_t)m * 1024 + n : xb + (size_t)(m - split) * 1024 + n;
        const float* gp = gate + cond_of(m) * 3072 + 2048 + n;
        const f32x4 x0 = *(const f32x4*)xr, x1 = *(const f32x4*)(xr + 4), g0 = *(const f32x4*)gp, g1 = *(const f32x4*)(gp + 4);
        *(u32x4*)(zp + (size_t)m * 1024 + n) = pk8(x0 * ALPHA + g0 * lo, x1 * ALPHA + g1 * hi);
    }
};
struct EpiInO {
    bf16_t *uo, *zo;
    DI void operator()(int, int m, int n, f32x4 lo, f32x4 hi) const {
        if (n < 2048) *(u32x4*)(uo + (size_t)m * 2048 + n) = pk8(lo, hi);
        else {
            f32x4 a, b;
#pragma unroll
            for (int e = 0; e < 4; ++e) { a[e] = siluf(lo[e]); b[e] = siluf(hi[e]); }
            *(u32x4*)(zo + (size_t)m * 2048 + (n - 2048)) = pk8(a, b);
        }
    }
};
struct EpiDftA {
    bf16_t *Tp, *Ts;
    DI void operator()(int z, int m, int n, f32x4 lo, f32x4 hi) const {
        const int cs = m >> 8, j = m & 255;
        const bool pr = n < NPTOK;
        const int sh = pr ? 8 : 10, nn = pr ? n : n - NPTOK, L = 1 << sh, bb = nn >> sh, l = nn & (L - 1);
        *(u32x4*)((pr ? Tp : Ts) + (unsigned)(((bb * 2048 + z * 256 + j) << (sh + 1)) + (cs << sh) + l)) = pk8(lo, hi);
    }
};
struct EpiDftB {
    bf16_t* mixed; int tok0, L;
    DI void operator()(int z, int m, int n, f32x4 lo, f32x4 hi) const { *(u32x4*)(mixed + ((size_t)(tok0 + z * L + m)) * 2048 + n) = pk8(lo, hi); }
};
struct EpiFno {
    const bf16_t* zo; bf16_t* y; const float* bias;
    DI void operator()(int, int m, int n, f32x4 lo, f32x4 hi) const {
        const f32x4 b0 = *(const f32x4*)(bias + n), b1 = *(const f32x4*)(bias + n + 4);
        f32x4 s0, s1; unpk8(*(const u32x4*)(zo + (size_t)m * 2048 + n), s0, s1);
        *(u32x4*)(y + (size_t)m * 2048 + n) = pk8((lo + b0) * s0, (hi + b1) * s1);
    }
};

DI void convert_wt(const float* W, bf16_t* Wt, int K, int N, char* smem, int rot, int p0, int p1) {
    const int half = threadIdx.x >> 8, tid = threadIdx.x & 255;
    float* tile = (float*)(smem + half * 16896);
    const int tn = N / 64, total = (K / 64) * tn, G = gridDim.x;
    int bid = (int)blockIdx.x - rot; bid %= G; if (bid < 0) bid += G;
    for (int t0 = bid * 2; t0 < total; t0 += G * 2) {
        const int t = t0 + half; const bool ok = t < total;
        const int k0 = (t / tn) * 64, n0 = (t % tn) * 64;
        __syncthreads();
        if (ok) { const int r = tid >> 4, c4 = (tid & 15) * 4;
#pragma unroll
          for (int i = 0; i < 4; ++i) { const f32x4 v = *(const f32x4*)(W + (size_t)(k0 + r + 16 * i) * N + n0 + c4);
              float* d = tile + (r + 16 * i) * 65 + c4; d[0] = v[0]; d[1] = v[1]; d[2] = v[2]; d[3] = v[3]; } }
        __syncthreads();
        if (ok) { const int n = tid >> 2, kq = (tid & 3) * 16; u32x4 w0, w1;
          const int rown = n0 + n, src = (rown >= p0 && rown < p1) ? (qk_perm(rown) - n0) : n;
          const float* s = tile + src;
          w0.x = pk2(s[(kq + 0) * 65], s[(kq + 1) * 65]); w0.y = pk2(s[(kq + 2) * 65], s[(kq + 3) * 65]); w0.z = pk2(s[(kq + 4) * 65], s[(kq + 5) * 65]); w0.w = pk2(s[(kq + 6) * 65], s[(kq + 7) * 65]);
          w1.x = pk2(s[(kq + 8) * 65], s[(kq + 9) * 65]); w1.y = pk2(s[(kq + 10) * 65], s[(kq + 11) * 65]); w1.z = pk2(s[(kq + 12) * 65], s[(kq + 13) * 65]); w1.w = pk2(s[(kq + 14) * 65], s[(kq + 15) * 65]);
          bf16_t* d = Wt + (size_t)rown * K + k0 + kq; *(u32x4*)d = w0; *(u32x4*)(d + 8) = w1; }
    }
    __syncthreads();
}

DI void convert_wt_sub(const float* W, bf16_t* Wt, int K, int N, char* smem, int bid, int G, int ldt = 0) {
    const int p0 = 0, p1 = 0;
    const int half = threadIdx.x >> 8, tid = threadIdx.x & 255;
    float* tile = (float*)(smem + half * 16896);
    const int tn = N / 64, total = (K / 64) * tn;
    for (int t0 = bid * 2; t0 < total; t0 += G * 2) {
        const int t = t0 + half; const bool ok = t < total;
        const int k0 = (t / tn) * 64, n0 = (t % tn) * 64;
        __syncthreads();
        if (ok) { const int r = tid >> 4, c4 = (tid & 15) * 4;
#pragma unroll
          for (int i = 0; i < 4; ++i) { const f32x4 v = *(const f32x4*)(W + (size_t)(k0 + r + 16 * i) * N + n0 + c4);
              float* d = tile + (r + 16 * i) * 65 + c4; d[0] = v[0]; d[1] = v[1]; d[2] = v[2]; d[3] = v[3]; } }
        __syncthreads();
        if (ok) { const int n = tid >> 2, kq = (tid & 3) * 16; u32x4 w0, w1;
          const int rown = n0 + n, src = (rown >= p0 && rown < p1) ? (qk_perm(rown) - n0) : n;
          const float* s = tile + src;
          w0.x = pk2(s[(kq + 0) * 65], s[(kq + 1) * 65]); w0.y = pk2(s[(kq + 2) * 65], s[(kq + 3) * 65]); w0.z = pk2(s[(kq + 4) * 65], s[(kq + 5) * 65]); w0.w = pk2(s[(kq + 6) * 65], s[(kq + 7) * 65]);
          w1.x = pk2(s[(kq + 8) * 65], s[(kq + 9) * 65]); w1.y = pk2(s[(kq + 10) * 65], s[(kq + 11) * 65]); w1.z = pk2(s[(kq + 12) * 65], s[(kq + 13) * 65]); w1.w = pk2(s[(kq + 14) * 65], s[(kq + 15) * 65]);
          bf16_t* d = Wt + (size_t)rown * (ldt ? ldt : K) + k0 + kq; *(u32x4*)d = w0; *(u32x4*)(d + 8) = w1; }
    }
    __syncthreads();
}

DI void ssm_params(const Params& p, char* smem, int bid, int nb) {
    const int half = threadIdx.x >> 8, tid = threadIdx.x & 255;
    f32x2* apow = (f32x2*)(smem + half * 51200);
    f32x2* Bb = apow + 2 * 17 * 64;
    f32x2* Cc = Bb + 2 * 64 * 16;
    bf16_t* WS = (bf16_t*)(p.ws + OFF_WS);
    bf16_t* WY = (bf16_t*)(p.ws + OFF_WY);
    for (int j0 = bid * 2; j0 < 128; j0 += nb * 2) {
        const int job = j0 + half, g = job >> 1, dsel = job & 1;
        __syncthreads();
        {
            const int d = tid >> 7, pp = (tid >> 1) & 63, th = tid & 1;
            const float lr = p.lam_re[(d * 64 + g) * 64 + pp], li = p.lam_im[(d * 64 + g) * 64 + pp], dt = expf(p.log_dt[d * 64 + g]);
#pragma unroll 1
            for (int tau = th; tau <= 16; tau += 2) { const float mag = expf(lr * dt * (float)tau); float s, c; sincosf(li * dt * (float)tau, &s, &c); apow[(d * 17 + tau) * 64 + pp] = (f32x2){mag * c, mag * s}; }
            float s1, c1, sh, chh; sincosf(li * dt, &s1, &c1); sincosf(0.5f * li * dt, &sh, &chh);
            const float em1 = expm1f(lr * dt), mag = em1 + 1.f;
            const float arm1 = em1 * c1 - 2.f * sh * sh, ai = mag * s1;
            const float den = lr * lr + li * li;
            const float fr = (arm1 * lr + ai * li) / den, fi = (ai * lr - arm1 * li) / den;
#pragma unroll 1
            for (int m = th * 8; m < th * 8 + 8; ++m) { const float br = p.b_re[((d * 64 + g) * 64 + pp) * 16 + m], bi = p.b_im[((d * 64 + g) * 64 + pp) * 16 + m];
                Bb[(d * 64 + pp) * 16 + m] = (f32x2){fr * br - fi * bi, fr * bi + fi * br}; }
        }
        for (int i = tid; i < 2048; i += 256) { const int d = i >> 10, n = (i >> 6) & 15, pp = i & 63; const size_t gi = ((size_t)(d * 64 + g) * 16 + n) * 64 + pp; Cc[i] = (f32x2){p.c_re[gi], p.c_im[gi]}; }
        __syncthreads();
        bf16_t* wy = WY + (size_t)g * 256 * 512;
        bf16_t* wsg = WS + (size_t)g * 256 * 256;
        {
            const int n = tid >> 4, m = tid & 15, d = dsel;
            float kk[16];
#pragma unroll
            for (int t = 0; t < 16; ++t) kk[t] = 0.f;
            float ko = 0.f;
#pragma unroll 1
            for (int pp = 0; pp < 64; ++pp) {
                const f32x2 cv = Cc[(d * 16 + n) * 64 + pp], bv = Bb[(d * 64 + pp) * 16 + m];
                const float cbr = cv.x * bv.x - cv.y * bv.y, cbi = cv.x * bv.y + cv.y * bv.x;
#pragma unroll
                for (int t = 0; t < 16; ++t) { const f32x2 a = apow[(d * 17 + t) * 64 + pp]; kk[t] += cbr * a.x - cbi * a.y; }
                const f32x2 co = Cc[((d ^ 1) * 16 + n) * 64 + pp], bo = Bb[((d ^ 1) * 64 + pp) * 16 + m];
                ko += co.x * bo.x - co.y * bo.y;
            }
            if (d == 0) {
#pragma unroll
                for (int tau = 1; tau < 16; ++tau) { const bf16_t v = f2bf(kk[tau]);
#pragma unroll 1
                    for (int t = tau; t < 16; ++t) wy[(size_t)(t * 16 + n) * 512 + (t - tau) * 16 + m] = v; }
            } else {
                const bf16_t dv = f2bf(ko + kk[0] + (n == m ? p.ssm_d[g * 16 + n] : 0.f));
#pragma unroll 1
                for (int t = 0; t < 16; ++t) wy[(size_t)(t * 16 + n) * 512 + t * 16 + m] = dv;
#pragma unroll
                for (int tau = 1; tau < 16; ++tau) { const bf16_t v = f2bf(kk[tau]);
#pragma unroll 1
                    for (int t = 0; t + tau < 16; ++t) wy[(size_t)(t * 16 + n) * 512 + (t + tau) * 16 + m] = v; }
            }
        }
        {
            const int d = dsel, c7 = tid & 127, ri = c7 >> 6, pp = c7 & 63, hx = tid >> 7, cidx = d * 128 + c7;
#pragma unroll 1
            for (int row = hx * 128; row < hx * 128 + 128; ++row) {
                const int t = row >> 4, n = row & 15, e = d == 0 ? t + 1 : 16 - t;
                const f32x2 cv = Cc[(d * 16 + n) * 64 + pp], a = apow[(d * 17 + e) * 64 + pp];
                const float v = ri == 0 ? (cv.x * a.x - cv.y * a.y) : -(cv.x * a.y + cv.y * a.x);
                wy[(size_t)row * 512 + 256 + cidx] = f2bf(v);
            }
#pragma unroll 1
            for (int s = hx * 8; s < hx * 8 + 8; ++s) {
                const int e = d == 0 ? 15 - s : s;
                const f32x2 a = apow[(d * 17 + e) * 64 + pp];
                float v[16];
#pragma unroll
                for (int m = 0; m < 16; ++m) { const f32x2 bv = Bb[(d * 64 + pp) * 16 + m]; v[m] = ri == 0 ? (a.x * bv.x - a.y * bv.y) : (a.x * bv.y + a.y * bv.x); }
                u32x4 w0, w1;
                w0.x = pk2(v[0], v[1]); w0.y = pk2(v[2], v[3]); w0.z = pk2(v[4], v[5]); w0.w = pk2(v[6], v[7]);
                w1.x = pk2(v[8], v[9]); w1.y = pk2(v[10], v[11]); w1.z = pk2(v[12], v[13]); w1.w = pk2(v[14], v[15]);
                bf16_t* dd = wsg + (size_t)cidx * 256 + s * 16; *(u32x4*)dd = w0; *(u32x4*)(dd + 8) = w1;
            }
        }
    }
    __syncthreads();
}

DI void mod_gemv(const Params& p, char* smem, int rot) {
    float* sc = (float*)smem;
    float* red = sc + 5 * 1024;
    float* modv = (float*)(p.ws + OFF_MOD);
    const int tid = threadIdx.x;
    int bid = (int)blockIdx.x - rot; bid %= (int)gridDim.x; if (bid < 0) bid += gridDim.x;
    if (bid >= 192) return;
    __syncthreads();
    for (int i = tid; i < 5 * 1024; i += 512) { const int ci = i >> 10, k = i & 1023; const float v = ci == 0 ? p.c_ctx[k] : p.c[(ci - 1) * 1024 + k]; sc[i] = siluf(v); }
    __syncthreads();
    for (int u = bid; u < 192; u += gridDim.x) {
        const int l = u / 96, c0 = (u % 96) * 32, c4 = (tid & 7) * 4, ks = tid >> 3;
        const float* w = p.w_mod + (size_t)l * 1024 * 3072 + c0 + c4;
        f32x4 wv[16];
#pragma unroll
        for (int j = 0; j < 16; ++j) wv[j] = *(const f32x4*)(w + (size_t)(ks * 16 + j) * 3072);
        f32x4 a[5];
#pragma unroll
        for (int ci = 0; ci < 5; ++ci) a[ci] = (f32x4){0.f, 0.f, 0.f, 0.f};
#pragma unroll
        for (int j = 0; j < 16; ++j)
#pragma unroll
            for (int ci = 0; ci < 5; ++ci) a[ci] = a[ci] + wv[j] * sc[ci * 1024 + ks * 16 + j];
#pragma unroll
        for (int ci = 0; ci < 5; ++ci)
#pragma unroll
            for (int e = 0; e < 4; ++e) red[(ks * 32 + c4 + e) * 5 + ci] = a[ci][e];
        __syncthreads();
        if (tid < 160) { const int ci = tid >> 5, cc = tid & 31; float sum = p.b_mod[l * 3072 + c0 + cc];
#pragma unroll 8
            for (int q = 0; q < 64; ++q) sum += red[(q * 32 + cc) * 5 + ci];
            modv[(l * 5 + ci) * 3072 + c0 + cc] = sum; }
        __syncthreads();
    }
}

DI void phase_prep(const Params& p, char* smem) {
    const int tid = threadIdx.x, G = gridDim.x;
    const size_t gt = (size_t)blockIdx.x * 512 + tid, gn = (size_t)G * 512;
    mod_gemv(p, smem, 64);
    convert_wt(p.w_in_e, (bf16_t*)(p.ws + OFF_WINE), 1024, 6144, smem, 0, 2048, 4096);
    { float* rc = (float*)(p.ws + OFF_ROPEC); float* rs = (float*)(p.ws + OFF_ROPES);
      for (size_t i = gt; i < 1024 * 32; i += gn) { const int pos = i >> 5, j = i & 31; const float fq = exp2f(-(float)(j & 15) * (13.287712379549449f / 16.f));
          const float ang = (float)(j < 16 ? (pos >> 6) : (pos & 63)) * fq; float s, c; sincosf(ang, &s, &c); rc[i] = c; rs[i] = s; } }
}
DI void phase_prep_late(const Params& p, char* smem, int bid, int nb) {
    const int tid = threadIdx.x;
    ssm_params(p, smem, bid, nb);
    if (bid < 64) return;
    const size_t gt = (size_t)(bid - 64) * 512 + tid, gn = (size_t)(nb - 64) * 512;
    if (bid == nb - 1 && tid < 64) {
        const float a = wave_sum(p.lq1[tid] * p.lk1[tid]), b = wave_sum(p.lq2[tid] * p.lk2[tid]);
        if (tid == 0) *(float*)(p.ws + OFF_LAM) = expf(a) - expf(b) + LAM_INIT;
    }
    { bf16_t* kS = (bf16_t*)(p.ws + OFF_KS);
      for (size_t i = gt; i < (size_t)4 * 256 * 256; i += gn) {
          const int b = i >> 16, r = i & 65535, pos = r >> 8, c4 = (r & 255) * 4;
          const f32x4 v = *(const f32x4*)(p.cache_k + ((size_t)(b * 256 + pos)) * 1024 + c4);
          *(u32x2*)(kS + ((size_t)(b * 1280 + pos)) * 1024 + c4) = pk4(v); } }
    for (int b = 0; b < 4; ++b)
        convert_wt_sub(p.cache_v + (size_t)b * 256 * 1024, (bf16_t*)(p.ws + OFF_VTS) + (size_t)b * 1024 * 1280, 256, 1024, smem, bid - 64, nb - 64, 1280);
}

DI void phase_prep_later(const Params& p, char* smem, int bid, int nb) {
    const int tid = threadIdx.x;
    const size_t gt = (size_t)bid * 512 + tid, gn = (size_t)nb * 512;
    convert_wt_sub(p.w_out_e, (bf16_t*)(p.ws + OFF_WOUTE), 2048, 1024, smem, bid, nb);
    { bf16_t* W = (bf16_t*)(p.ws + OFF_WDFT);
      for (size_t i = gt; i < 512 * 256; i += gn) { const int c = i & 255, j = (i >> 8) & 255, cs = i >> 16; const float x = 2.f * (float)((j * c) & 255) / 256.f; W[i] = f2bf((cs ? sinpif(x) : cospif(x)) * 0.0625f); } }
    { bf16_t* W = (bf16_t*)(p.ws + OFF_DL256);
      for (size_t i = gt; i < 256 * 512; i += gn) { const int col = i & 511, k = i >> 9, cs = col >> 8, l = col & 255; const float x = 2.f * (float)((k * l) & 255) / 256.f; W[i] = f2bf((cs ? -sinpif(x) : cospif(x)) * 0.0625f); } }
    { bf16_t* W = (bf16_t*)(p.ws + OFF_DL1K);
      for (size_t i = gt; i < 1024 * 2048; i += gn) { const int col = i & 2047, k = i >> 11, cs = col >> 10, l = col & 1023; const float x = 2.f * (float)((k * l) & 1023) / 1024.f; W[i] = f2bf((cs ? -sinpif(x) : cospif(x)) * 0.03125f); } }
}

DI void phase_ln0(const Params& p) {
    const int lane = threadIdx.x & 63, wid = threadIdx.x >> 6;
    const float* modv = (const float*)(p.ws + OFF_MOD);
    bf16_t* h = (bf16_t*)(p.ws + OFF_H0);
    const int stride = gridDim.x * 8;
    f32x4 nv[4];
    { const float* xr = xin(p, blockIdx.x * 8 + wid);
#pragma unroll
      for (int i = 0; i < 4; ++i) nv[i] = *(const f32x4*)(xr + i * 256 + lane * 4); }
    for (int tok = blockIdx.x * 8 + wid; tok < NTOK; tok += stride) {
        f32x4 v[4]; float s = 0.f;
#pragma unroll
        for (int i = 0; i < 4; ++i) v[i] = nv[i];
        if (tok + stride < NTOK) {
            const float* xr = xin(p, tok + stride);
#pragma unroll
            for (int i = 0; i < 4; ++i) nv[i] = *(const f32x4*)(xr + i * 256 + lane * 4);
        }
#pragma unroll
        for (int i = 0; i < 4; ++i) s += v[i][0] + v[i][1] + v[i][2] + v[i][3];
        const float mu = wave_sum(s) * (1.f / 1024.f);
        float q = 0.f;
#pragma unroll
        for (int i = 0; i < 4; ++i) { v[i] = v[i] - mu; q += v[i][0] * v[i][0] + v[i][1] * v[i][1] + v[i][2] * v[i][2] + v[i][3] * v[i][3]; }
        const float rstd = rsqrtf(wave_sum(q) * (1.f / 1024.f) + LN_EPS);
        const float* md = modv + (0 * 5 + cond_of(tok)) * 3072;
#pragma unroll
        for (int i = 0; i < 4; ++i) { const int c = i * 256 + lane * 4; const f32x4 sh = *(const f32x4*)(md + c), sc = *(const f32x4*)(md + 1024 + c);
            *(u32x2*)(h + (size_t)tok * 1024 + c) = pk4(v[i] * rstd * (sc + 1.f) + sh); }
    }
}
DI void phase_ln_mid(const Params& p) {
    const int lane = threadIdx.x & 63, wid = threadIdx.x >> 6;
    const float* modv = (const float*)(p.ws + OFF_MOD);
    const bf16_t* zp = (const bf16_t*)(p.ws + OFF_UCOMB);
    bf16_t* h = (bf16_t*)(p.ws + OFF_H1);
    const int stride = gridDim.x * 8;
    u32x2 nv[4];
    { const bf16_t* xr = zp + (size_t)(blockIdx.x * 8 + wid) * 1024;
#pragma unroll
      for (int i = 0; i < 4; ++i) nv[i] = *(const u32x2*)(xr + i * 256 + lane * 4); }
    for (int tok = blockIdx.x * 8 + wid; tok < NTOK; tok += stride) {
        f32x4 v[4]; float s = 0.f;
#pragma unroll
        for (int i = 0; i < 4; ++i) v[i] = unpk4(nv[i]);
        if (tok + stride < NTOK) {
            const bf16_t* xr = zp + (size_t)(tok + stride) * 1024;
#pragma unroll
            for (int i = 0; i < 4; ++i) nv[i] = *(const u32x2*)(xr + i * 256 + lane * 4);
        }
#pragma unroll
        for (int i = 0; i < 4; ++i) s += v[i][0] + v[i][1] + v[i][2] + v[i][3];
        float mu = wave_sum(s) * (1.f / 1024.f);
        float q = 0.f;
#pragma unroll
        for (int i = 0; i < 4; ++i) { v[i] = v[i] - mu; q += v[i][0] * v[i][0] + v[i][1] * v[i][1] + v[i][2] * v[i][2] + v[i][3] * v[i][3]; }
        float rstd = rsqrtf(wave_sum(q) * (1.f / 1024.f) + LN_EPS);
        s = 0.f;
#pragma unroll
        for (int i = 0; i < 4; ++i) { const int c = i * 256 + lane * 4; const f32x4 gg = *(const f32x4*)(p.ln_g + c), bb = *(const f32x4*)(p.ln_b + c);
            v[i] = v[i] * rstd * gg + bb; *(f32x4*)(p.out + OUT_Y + (size_t)tok * 1024 + c) = v[i]; s += v[i][0] + v[i][1] + v[i][2] + v[i][3]; }
        mu = wave_sum(s) * (1.f / 1024.f); q = 0.f;
#pragma unroll
        for (int i = 0; i < 4; ++i) { v[i] = v[i] - mu; q += v[i][0] * v[i][0] + v[i][1] * v[i][1] + v[i][2] * v[i][2] + v[i][3] * v[i][3]; }
        rstd = rsqrtf(wave_sum(q) * (1.f / 1024.f) + LN_EPS);
        const float* md = modv + (1 * 5 + cond_of(tok)) * 3072;
#pragma unroll
        for (int i = 0; i < 4; ++i) { const int c = i * 256 + lane * 4; const f32x4 sh = *(const f32x4*)(md + c), sc = *(const f32x4*)(md + 1024 + c);
            *(u32x2*)(h + (size_t)tok * 1024 + c) = pk4(v[i] * rstd * (sc + 1.f) + sh); }
    }
}
DI void phase_ln_final(const Params& p) {
    const int lane = threadIdx.x & 63, wid = threadIdx.x >> 6;
    const bf16_t* zp = (const bf16_t*)(p.ws + OFF_UO);
    const int stride = gridDim.x * 8;
    u32x2 nv[4];
    { const bf16_t* xr = zp + (size_t)(blockIdx.x * 8 + wid) * 1024;
#pragma unroll
      for (int i = 0; i < 4; ++i) nv[i] = *(const u32x2*)(xr + i * 256 + lane * 4); }
    for (int tok = blockIdx.x * 8 + wid; tok < NTOK; tok += stride) {
        f32x4 v[4]; float s = 0.f;
#pragma unroll
        for (int i = 0; i < 4; ++i) v[i] = unpk4(nv[i]);
        if (tok + stride < NTOK) {
            const bf16_t* xr = zp + (size_t)(tok + stride) * 1024;
#pragma unroll
            for (int i = 0; i < 4; ++i) nv[i] = *(const u32x2*)(xr + i * 256 + lane * 4);
        }
#pragma unroll
        for (int i = 0; i < 4; ++i) s += v[i][0] + v[i][1] + v[i][2] + v[i][3];
        const float mu = wave_sum(s) * (1.f / 1024.f);
        float q = 0.f;
#pragma unroll
        for (int i = 0; i < 4; ++i) { v[i] = v[i] - mu; q += v[i][0] * v[i][0] + v[i][1] * v[i][1] + v[i][2] * v[i][2] + v[i][3] * v[i][3]; }
        const float rstd = rsqrtf(wave_sum(q) * (1.f / 1024.f) + LN_EPS);
#pragma unroll
        for (int i = 0; i < 4; ++i) { const int c = i * 256 + lane * 4; const f32x4 gg = *(const f32x4*)(p.ln_g + 1024 + c), bb = *(const f32x4*)(p.ln_b + 1024 + c);
            *(f32x4*)(p.out + OUT_Y + (size_t)tok * 1024 + c) = v[i] * rstd * gg + bb; }
    }
}

template <int NI>
DI void carry_items(const Params& p, int g, const int (&seq)[NI], const int (&d)[NI], int pp) {
    const float* S = p.out + OUT_Y;
    bf16_t* ucomb = (bf16_t*)(p.ws + OFF_UCOMB);
    float ar[NI], ai[NI], Hr[NI], Hi[NI]; int chunk0[NI];
    const int nc = seq[0] < 32 ? 16 : 64;
#pragma unroll
    for (int q = 0; q < NI; ++q) {
        const float lr = p.lam_re[(d[q] * 64 + g) * 64 + pp], li = p.lam_im[(d[q] * 64 + g) * 64 + pp], dt = expf(p.log_dt[d[q] * 64 + g]);
        const float mag = expf(16.f * lr * dt); float sn, cs; sincosf(16.f * li * dt, &sn, &cs);
        ar[q] = mag * cs; ai[q] = mag * sn; Hr[q] = 0.f; Hi[q] = 0.f;
        if (seq[q] < 32) chunk0[q] = seq[q] * 16;
        else { const int sb = seq[q] - 32; chunk0[q] = 512 + sb * 64; const int si = ((sb * 2 + d[q]) * 64 + g) * 64 + pp; Hr[q] = p.st_re[si]; Hi[q] = p.st_im[si]; }
    }
    float sr[2][NI][8], si[2][NI][8];
#define CARRY_LOAD(SET, C8) do { _Pragma("unroll") for (int q = 0; q < NI; ++q) _Pragma("unroll") for (int j = 0; j < 8; ++j) { \
        const int chunk = chunk0[q] + (d[q] == 0 ? (C8) + j : nc - 1 - (C8) - j); const size_t row = (size_t)(g * 768 + chunk); \
        sr[SET][q][j] = S[row * 256 + d[q] * 128 + pp]; si[SET][q][j] = S[row * 256 + d[q] * 128 + 64 + pp]; } } while (0)
#define CARRY_STEP(SET, C8) do { _Pragma("unroll") for (int q = 0; q < NI; ++q) _Pragma("unroll") for (int j = 0; j < 8; ++j) { \
        const int chunk = chunk0[q] + (d[q] == 0 ? (C8) + j : nc - 1 - (C8) - j); const size_t row = (size_t)(g * 768 + chunk); \
        ucomb[row * 512 + 256 + d[q] * 128 + pp] = f2bf(Hr[q]); ucomb[row * 512 + 256 + d[q] * 128 + 64 + pp] = f2bf(Hi[q]); \
        const float nr = ar[q] * Hr[q] - ai[q] * Hi[q] + sr[SET][q][j], ni = ar[q] * Hi[q] + ai[q] * Hr[q] + si[SET][q][j]; Hr[q] = nr; Hi[q] = ni; } } while (0)
    CARRY_LOAD(0, 0);
    for (int c8 = 0; c8 < nc; c8 += 16) {
        CARRY_LOAD(1, c8 + 8);
        CARRY_STEP(0, c8);
        if (c8 + 16 < nc) CARRY_LOAD(0, c8 + 16);
        CARRY_STEP(1, c8 + 8);
    }
#undef CARRY_LOAD
#undef CARRY_STEP
#pragma unroll
    for (int q = 0; q < NI; ++q) if (seq[q] < 32) { const int oi = ((seq[q] * 2 + d[q]) * 64 + g) * 64 + pp; p.out[OUT_SR + oi] = Hr[q]; p.out[OUT_SI + oi] = Hi[q]; }
}
DI void carry_local(const Params& p, int g, int pm) {
    const int tid = threadIdx.x;
    if (pm < 2) {
#pragma unroll 1
        for (int h2 = 0; h2 < 2; ++h2) {
            int seq[2], d[2];
#pragma unroll
            for (int j = 0; j < 2; ++j) { const int item = tid + 512 * (2 * h2 + j); seq[j] = pm * 16 + (item >> 7); d[j] = (item >> 6) & 1; }
            carry_items<2>(p, g, seq, d, tid & 63);
        }
    } else { const int seq[1] = {32 + (tid >> 7)}, d[1] = {(tid >> 6) & 1}; carry_items<1>(p, g, seq, d, tid & 63); }
}

DI void phase_attn(const Params& p, char* smem_all) {
    const int team = threadIdx.x >> 8, tid = threadIdx.x & 255, lane = tid & 63, wid = tid >> 6, l31 = lane & 31, hh = lane >> 5;
    const int mp = wid >> 1, qsub = wid & 1;
    char* smem = smem_all + team * 36864;
    bf16_t* sK = (bf16_t*)smem;
    char* sV = smem + 16384;
    float* ex = (float*)smem;
    const bf16_t* Q = (const bf16_t*)(p.ws + OFF_Q);
    bf16_t* yab = (bf16_t*)(p.ws + OFF_YAB);
    const float lam = *(const float*)(p.ws + OFF_LAM);
    const int w = blockIdx.x;
    const int n_it = w < 128 ? 3 : (w < 192 ? 2 : 4);
    for (int it = 0; it < n_it; ++it) {
        const int sp = (w & 7) * 32 + (w >> 3);
        const int pair = w < 192 ? (it == 0 ? sp : (it == 1 ? 256 + w : 448 + w)) : (it == 0 ? sp : 576 + (w - 192) * 3 + (it - 1));
        const int u = pair * 2 + team;
        int hd, Lk, tokq, ldv; const bf16_t *Kb, *Vb;
        if (u < 512) { const int b = u >> 7, r = u & 127; hd = r >> 4; const int qt = r & 15; Lk = 1280; ldv = 1280; tokq = NPTOK + b * 1024 + qt * 64;
            Kb = (const bf16_t*)(p.ws + OFF_KS) + (size_t)b * 1280 * 1024; Vb = (const bf16_t*)(p.ws + OFF_VTS) + (size_t)b * 1024 * 1280; }
        else { const int uu = u - 512, b = uu >> 5, r = uu & 31; hd = r >> 2; const int qt = r & 3; Lk = 256; ldv = 256; tokq = b * 256 + qt * 64;
            Kb = (const bf16_t*)(p.ws + OFF_KP) + (size_t)b * 256 * 1024; Vb = (const bf16_t*)(p.ws + OFF_VTP) + (size_t)b * 1024 * 256; }
        const int tok = tokq + qsub * 32 + l31;
        bf16x8 qf[4];
#pragma unroll
        for (int ks = 0; ks < 4; ++ks) qf[ks] = *(const bf16x8*)(Q + (size_t)tok * 1024 + hd * 128 + mp * 64 + ks * 16 + hh * 8);
        f32x16 o[4];
#pragma unroll
        for (int vb = 0; vb < 4; ++vb)
#pragma unroll
            for (int i = 0; i < 16; ++i) o[vb][i] = 0.f;
        float m_run = -1e30f, l_run = 0.f;
        const int nkt = Lk >> 6;
        u32x4 rk[4], rv[4];
#pragma unroll
        for (int i = 0; i < 4; ++i) { const int idx = tid + 256 * i, mm = idx >> 9, key = (idx >> 3) & 63, ch = idx & 7, vd = idx >> 3;
            rk[i] = *(const u32x4*)(Kb + (size_t)key * 1024 + hd * 128 + mm * 64 + ch * 8);
            rv[i] = *(const u32x4*)(Vb + (size_t)(hd * 128 + vd) * ldv + ch * 8); }
        for (int kt = 0; kt < nkt; ++kt) {
            __syncthreads();
#pragma unroll
            for (int i = 0; i < 4; ++i) { const int idx = tid + 256 * i, mm = idx >> 9, key = (idx >> 3) & 63, ch = idx & 7;
                *(u32x4*)(sK + (mm * 64 + key) * 64 + ((ch ^ (key & 7)) * 8)) = rk[i];
                const int vd = idx >> 3; char* d = sV + vd * 136 + ch * 16;
                *(u32x2*)d = (u32x2){rv[i].x, rv[i].y}; *(u32x2*)(d + 8) = (u32x2){rv[i].z, rv[i].w}; }
            __syncthreads();
            if (kt + 1 < nkt) {
#pragma unroll
                for (int i = 0; i < 4; ++i) { const int idx = tid + 256 * i, mm = idx >> 9, key = (idx >> 3) & 63, ch = idx & 7, vd = idx >> 3;
                    rk[i] = *(const u32x4*)(Kb + (size_t)((kt + 1) * 64 + key) * 1024 + hd * 128 + mm * 64 + ch * 8);
                    rv[i] = *(const u32x4*)(Vb + (size_t)(hd * 128 + vd) * ldv + (kt + 1) * 64 + ch * 8); }
            }
            f32x16 s[2];
#pragma unroll
            for (int kb = 0; kb < 2; ++kb) {
#pragma unroll
                for (int i = 0; i < 16; ++i) s[kb][i] = 0.f;
#pragma unroll
                for (int ks = 0; ks < 4; ++ks) {
                    const bf16x8 kf = *(const bf16x8*)(sK + (mp * 64 + kb * 32 + l31) * 64 + (((ks * 2 + hh) ^ (l31 & 7)) * 8));
                    s[kb] = __builtin_amdgcn_mfma_f32_32x32x16_bf16(kf, qf[ks], s[kb], 0, 0, 0);
                }
            }
            float mx = s[0][0];
#pragma unroll
            for (int i = 0; i < 16; ++i) { mx = fmaxf(mx, s[0][i]); mx = fmaxf(mx, s[1][i]); }
            mx = fmaxf(mx, __shfl_xor(mx, 32));
            const float mnew = fmaxf(m_run, mx);
            const float alpha = __builtin_amdgcn_exp2f((m_run - mnew) * LOG2E);
            const float mneg = -mnew * LOG2E;
            float rs = 0.f;
#pragma unroll
            for (int kb = 0; kb < 2; ++kb)
#pragma unroll
                for (int i = 0; i < 16; ++i) { const float e = __builtin_amdgcn_exp2f(__builtin_fmaf(s[kb][i], LOG2E, mneg)); s[kb][i] = e; rs += e; }
            rs += __shfl_xor(rs, 32);
            l_run = l_run * alpha + rs; m_run = mnew;
#pragma unroll
            for (int vb = 0; vb < 4; ++vb)
#pragma unroll
                for (int i = 0; i < 16; ++i) o[vb][i] *= alpha;
#pragma unroll
            for (int kb = 0; kb < 2; ++kb)
#pragma unroll
                for (int s2 = 0; s2 < 2; ++s2) {
                    u32x4 pw; pw.x = pk2(s[kb][8 * s2], s[kb][8 * s2 + 1]); pw.y = pk2(s[kb][8 * s2 + 2], s[kb][8 * s2 + 3]); pw.z = pk2(s[kb][8 * s2 + 4], s[kb][8 * s2 + 5]); pw.w = pk2(s[kb][8 * s2 + 6], s[kb][8 * s2 + 7]);
                    const bf16x8 pf = __builtin_bit_cast(bf16x8, pw);
#pragma unroll
                    for (int vb = 0; vb < 4; ++vb) {
                        const char* a = sV + (vb * 32 + l31) * 136 + (kb * 32 + 16 * s2 + 4 * hh) * 2;
                        const s16x4 v0 = *(const s16x4*)a, v1 = *(const s16x4*)(a + 16);
                        const bf16x8 vf = __builtin_shufflevector(v0, v1, 0, 1, 2, 3, 4, 5, 6, 7);
                        o[vb] = __builtin_amdgcn_mfma_f32_32x32x16_bf16(vf, pf, o[vb], 0, 0, 0);
                    }
                }
        }
        const float inv = 1.f / l_run;
        __syncthreads();
        if (mp == 1) {
#pragma unroll
            for (int vb = 0; vb < 4; ++vb)
#pragma unroll
                for (int i = 0; i < 16; ++i) ex[(qsub * 128 + vb * 32 + (i & 3) + 8 * (i >> 2) + 4 * hh) * 32 + l31] = o[vb][i] * inv;
        }
        __syncthreads();
        if (mp == 0) {
            float ss = 0.f;
#pragma unroll
            for (int vb = 0; vb < 4; ++vb)
#pragma unroll
                for (int i = 0; i < 16; ++i) { const float v = o[vb][i] * inv - lam * ex[(qsub * 128 + vb * 32 + (i & 3) + 8 * (i >> 2) + 4 * hh) * 32 + l31]; o[vb][i] = v; ss += v * v; }
            ss += __shfl_xor(ss, 32);
            const float rms = rsqrtf(ss * (1.f / 128.f) + LN_EPS) * (1.f - LAM_INIT);
#pragma unroll
            for (int vb = 0; vb < 4; ++vb)
#pragma unroll
                for (int q4 = 0; q4 < 4; ++q4) {
                    const int vd = vb * 32 + 8 * q4 + 4 * hh;
                    const f32x4 gg = *(const f32x4*)(p.subln_g + vd);
                    bf16_t* dst = yab + (size_t)tok * 2048 + 1024 + hd * 128 + vd;
                    const f32x4 sz = unpk4(*(const u32x2*)dst);
                    f32x4 r;
#pragma unroll
                    for (int e = 0; e < 4; ++e) r[e] = o[vb][4 * q4 + e] * rms * gg[e] * sz[e];
                    *(u32x2*)dst = pk4(r);
                }
        }
        __syncthreads();
    }
}
#define XB_TMO      128
#define XB_XCNT(j)  (256  + 64 * (j))
#define XB_XSUB(j)  (1280 + 64 * (j))
#define XB_XGEN(j)  (2304 + 64 * (j))
#define XB_TOP      3328
#define XB_TOPGEN   3392
#define XCD_BAR_WORDS 3456
#define XB_SPIN_CAP (1u << 20)
DI unsigned xb_ld(unsigned* p)              { return __hip_atomic_load(p, __ATOMIC_RELAXED, __HIP_MEMORY_SCOPE_AGENT); }
DI unsigned xb_add(unsigned* p, unsigned v) { return __hip_atomic_fetch_add(p, v, __ATOMIC_RELAXED, __HIP_MEMORY_SCOPE_AGENT); }
DI unsigned xb_xcc_id() { return (unsigned)__builtin_amdgcn_s_getreg((3 << 11) | 20) & 0xFu; }
#define XB_SPIN(cond, bar) do { unsigned _sp = 0; while (cond) { __builtin_amdgcn_s_sleep(1); \
    if ((++_sp & 255u) == 0u) { if (xb_ld(&(bar)[XB_TMO])) break; if (_sp > XB_SPIN_CAP) { atomicAdd(&(bar)[XB_TMO], 1u); break; } } } } while (0)
struct XcdBarrier { unsigned* bar; unsigned x; volatile unsigned* st; };
DI XcdBarrier xb_init(unsigned* bar, volatile unsigned* st) {
    XcdBarrier b; b.bar = bar; b.x = xb_xcc_id(); b.st = st;
    if (threadIdx.x == 0) {
        (void)xb_add(&bar[XB_XCNT(b.x)], 1u);
        const unsigned G = gridDim.x;
        unsigned sum, cnt, mine, sp = 0u;
        for (;;) {
            sum = 0u; cnt = 0u; mine = 0u;
#pragma unroll
            for (unsigned j = 0; j < 16; ++j) { const unsigned c = xb_ld(&bar[XB_XCNT(j)]); sum += c; cnt += (c > 0u) ? 1u : 0u; mine = (j == b.x) ? c : mine; }
            if (sum == G) break;
            __builtin_amdgcn_s_sleep(1);
            if ((++sp & 255u) == 0u) { if (xb_ld(&bar[XB_TMO])) break; if (sp > XB_SPIN_CAP) { atomicAdd(&bar[XB_TMO], 1u); break; } }
        }
        st[0] = mine > 0u ? mine : 1u; st[1] = cnt > 0u ? cnt : 1u;
    }
    return b;
}
DI void xcd_barrier(const XcdBarrier& b) {
    asm volatile("s_waitcnt vmcnt(0)" ::: "memory");
    __syncthreads();
    if (threadIdx.x == 0) {
        unsigned* bar = b.bar;
        __builtin_amdgcn_s_waitcnt(0);
        const unsigned nloc = b.st[0], nx = b.st[1];
        const unsigned old = xb_add(&bar[XB_XSUB(b.x)], 1u);
        const unsigned gen = old / nloc;
        if (old + 1u == (gen + 1u) * nloc) {
            __builtin_amdgcn_fence(__ATOMIC_RELEASE, "agent");
            asm volatile("s_waitcnt vmcnt(0)" ::: "memory");
            const unsigned og = xb_add(&bar[XB_TOP], 1u);
            const unsigned tg = og / nx;
            if (og + 1u == (tg + 1u) * nx) xb_add(&bar[XB_TOPGEN], 1u);
            else XB_SPIN(xb_ld(&bar[XB_TOPGEN]) == tg, bar);
            __builtin_amdgcn_fence(__ATOMIC_ACQUIRE, "agent");
            xb_add(&bar[XB_XGEN(b.x)], 1u);
            asm volatile("s_waitcnt vmcnt(0)" ::: "memory");
        } else {
            XB_SPIN(xb_ld(&bar[XB_XGEN(b.x)]) == gen, bar);
            __builtin_amdgcn_fence(__ATOMIC_ACQUIRE, "agent");
            asm volatile("s_waitcnt vmcnt(0)" ::: "memory");
        }
    }
    __syncthreads();
}

DI void warm_code(unsigned long long base) {
    if (threadIdx.x < 416) {
        const char* a = (const char*)base + ((blockIdx.x >> 3) & 31) * 6656 + threadIdx.x * 16;
        u32x4 t;
        asm volatile("global_load_dwordx4 %0, %1, off\n\ts_waitcnt vmcnt(0)" : "=v"(t) : "v"(a) : "memory");
    }
}

#ifndef ONLY
#define ONLY -1
#endif
#define PHASE(i, ...) if ((ONLY < 0 || ONLY == (i)) && ph_lo <= (i) && (i) < ph_hi) { if ((i) > ph_lo) { warm_code(code_base); xcd_barrier(xb); } __VA_ARGS__ }

constexpr int LDS_BYTES = 147456;
__global__ void __launch_bounds__(512, 2) mega(Params p, int ph_lo, int ph_hi) {
    extern __shared__ __attribute__((aligned(16))) unsigned char lds_raw[];
    PG8_LAS unsigned char* lds = (PG8_LAS unsigned char*)lds_raw;
    char* smem = (char*)lds_raw;
    cg::grid_group grid = cg::this_grid();
    char* ws = p.ws;
    if (ph_lo < 0) grid.sync();
    unsigned long long code_base = __builtin_amdgcn_s_getpc() & ~0xFFFull;
    asm volatile("" : "+s"(code_base));
    warm_code(code_base);
    const XcdBarrier xb = xb_init((unsigned*)(ws + OFF_BAR), (volatile unsigned*)(lds_raw + LDS_BYTES - 16));
    const float* modv = (const float*)(ws + OFF_MOD);
    PHASE(0, { if (blockIdx.x < 64) convert_wt_sub(p.w_glu, (bf16_t*)(ws + OFF_WGLU), 1024, 1024, smem, (int)blockIdx.x, 64);
               phase_prep(p, smem); })
    PHASE(1, { phase_ln0(p); })
    PHASE(2, {
        GemmDesc g{(const bf16_t*)(ws + OFF_H0), (const bf16_t*)(ws + OFF_WINE), 0, 0, 1024, 1024, NTOK, 6144, 1024, 1};
        EpiInE e{(bf16_t*)(ws + OFF_UCOMB), (bf16_t*)(ws + OFF_YAB), (bf16_t*)(ws + OFF_Q), (bf16_t*)(ws + OFF_KP), (bf16_t*)(ws + OFF_KS), (bf16_t*)(ws + OFF_VTP), (bf16_t*)(ws + OFF_VTS), p.out,
                 (const float*)(ws + OFF_ROPEC), (const float*)(ws + OFF_ROPES)};
        gemm_run(g, e, lds);
        if (blockIdx.x >= 128) phase_prep_late(p, smem, (int)blockIdx.x - 128, 128); })
    PHASE(3, {
        { GemmDesc g{(const bf16_t*)(ws + OFF_UCOMB), (const bf16_t*)(ws + OFF_WS), 768L * 512, 256L * 256, 512, 256, 768, 256, 256, 64};
          EpiS e{p.out + OUT_Y};
          gemm_run(g, e, lds); }
        __threadfence_block(); __syncthreads();
        if (blockIdx.x < 192) carry_local(p, (int)blockIdx.x / 3, (int)blockIdx.x % 3);
        __threadfence_block(); __syncthreads();
        { GemmDesc g{(const bf16_t*)(ws + OFF_UCOMB), (const bf16_t*)(ws + OFF_WY), 768L * 512, 256L * 512, 512, 512, 768, 256, 512, 64};
          EpiY e{(bf16_t*)(ws + OFF_H0)};
          gemm_run(g, e, lds); }
        phase_attn(p, smem); })
    PHASE(4, {
        GemmDesc g{(const bf16_t*)(ws + OFF_H0), (const bf16_t*)(ws + OFF_WGLU), 0, 0, 1024, 1024, NTOK, 1024, 1024, 1};
        EpiGlu e{(const bf16_t*)(ws + OFF_H0), (bf16_t*)(ws + OFF_YAB), p.b_glu};
        gemm_run(g, e, lds);
        if (blockIdx.x >= 192) { phase_prep_later(p, smem, (int)blockIdx.x - 192, 64);
            convert_wt_sub(p.w_out_o, (bf16_t*)(ws + OFF_WOUTO), 2048, 1024, smem, (int)blockIdx.x - 192, 64); } })
    PHASE(5, {
        GemmDesc g{(const bf16_t*)(ws + OFF_YAB), (const bf16_t*)(ws + OFF_WOUTE), 0, 0, 2048, 2048, NTOK, 1024, 2048, 1};
        EpiRes e{p.x_prompt, p.x_sample, NPTOK, modv, (bf16_t*)(ws + OFF_UCOMB)};
        gemm_run(g, e, lds);
        if (blockIdx.x >= 192) {
            convert_wt_sub(p.w_in_o, (bf16_t*)(ws + OFF_WINO), 1024, 4096, smem, (int)blockIdx.x - 192, 64);
            convert_wt_sub(p.w_fno, (bf16_t*)(ws + OFF_WFNO), 2048, 2048, smem, (int)blockIdx.x - 192, 64);
 } })
    PHASE(6, { phase_ln_mid(p); })
    PHASE(7, {
        GemmDesc g{(const bf16_t*)(ws + OFF_H1), (const bf16_t*)(ws + OFF_WINO), 0, 0, 1024, 1024, NTOK, 4096, 1024, 1};
        EpiInO e{(bf16_t*)(ws + OFF_UO), (bf16_t*)(ws + OFF_ZO)};
        gemm_run(g, e, lds); })
    PHASE(8, {
        GemmDesc g{(const bf16_t*)(ws + OFF_WDFT), (const bf16_t*)(ws + OFF_UO), 0, 256, 256, 2048, 512, NTOK, 256, 8};
        EpiDftA e{(bf16_t*)(ws + OFF_TP), (bf16_t*)(ws + OFF_TS)};
        gemm_run(g, e, lds); })
    PHASE(9, {
        { GemmDesc g{(const bf16_t*)(ws + OFF_DL1K), (const bf16_t*)(ws + OFF_TS), 0, 2048L * 2048, 2048, 2048, 1024, 2048, 2048, 4};
          EpiDftB e{(bf16_t*)(ws + OFF_UO), NPTOK, 1024};
          gemm_run(g, e, lds); }
        { GemmDesc g{(const bf16_t*)(ws + OFF_DL256), (const bf16_t*)(ws + OFF_TP), 0, 2048L * 512, 512, 512, 256, 2048, 512, 32};
          EpiDftB e{(bf16_t*)(ws + OFF_UO), 0, 256};
          gemm_run(g, e, lds, 128, 128); } })
    PHASE(10, {
        GemmDesc g{(const bf16_t*)(ws + OFF_UO), (const bf16_t*)(ws + OFF_WFNO), 0, 0, 2048, 2048, NTOK, 2048, 2048, 1};
        EpiFno e{(const bf16_t*)(ws + OFF_ZO), (bf16_t*)(ws + OFF_Y1), p.b_fno};
        gemm_run(g, e, lds); })
    PHASE(11, {
        GemmDesc g{(const bf16_t*)(ws + OFF_Y1), (const bf16_t*)(ws + OFF_WOUTO), 0, 0, 2048, 2048, NTOK, 1024, 2048, 1};
        EpiRes e{p.out + OUT_Y, p.out + OUT_Y, NTOK, modv + 5 * 3072, (bf16_t*)(ws + OFF_UO)};
        gemm_run(g, e, lds); })
    PHASE(12, { phase_ln_final(p); })
}

extern "C" void kernel_launch(void* const* d_in, const int* in_sizes, int n_in, void* d_out, int out_size, void* d_ws, size_t ws_size, hipStream_t stream) {
    (void)in_sizes; (void)n_in; (void)out_size; (void)ws_size;
    Params p{};
    const float** f = (const float**)&p;
    for (int i = 0; i < 33; ++i) f[i] = (const float*)d_in[i];
    p.out = (float*)d_out; p.ws = (char*)d_ws;
    static int grid_blocks = 0;
    if (!grid_blocks) {
        int dev = 0, cus = 0, per_cu = 0;
        (void)hipGetDevice(&dev);
        (void)hipDeviceGetAttribute(&cus, hipDeviceAttributeMultiprocessorCount, dev);
        (void)hipFuncSetAttribute((const void*)mega, hipFuncAttributeMaxDynamicSharedMemorySize, LDS_BYTES);
        (void)hipOccupancyMaxActiveBlocksPerMultiprocessor(&per_cu, mega, 512, LDS_BYTES);
        if (per_cu > 1) per_cu = 1;
        if (per_cu < 1) per_cu = 1;
        grid_blocks = cus * per_cu;
    }
    (void)hipMemsetAsync((char*)d_ws + OFF_BAR, 0, XCD_BAR_WORDS * sizeof(unsigned), stream);
    int lo = 0, hi = 13;
    void* args[] = {&p, &lo, &hi};
    hipError_t e = hipLaunchCooperativeKernel((void*)mega, dim3(grid_blocks), dim3(512), args, LDS_BYTES, stream);
    if (e != hipSuccess) fprintf(stderr, "cooperative launch failed: %s (grid %d)\n", hipGetErrorString(e), grid_blocks);
}
```
